# Optimizing an MI355X kernel written in HIP

```python
import math
import jax, jax.numpy as jnp
from jax import lax
import numpy as np

D_MODEL = 1024
BATCH = 2
SEQ = 8192
DEPTH = 2

PLE_DIM = 256
N_MIXERS = 2
HEAD_DIM = 64
BLOCK = 128
DIL_CONFIGS = ((128, 1), (512, 4), (2048, 16))
N_GROUPS_A = len(DIL_CONFIGS)
HEADS_A = D_MODEL // HEAD_DIM
HEADS_B = D_MODEL // (2 * HEAD_DIM)
D_FF = 4 * D_MODEL
N_BUCKETS = 32
MAX_DISTANCE = 2048
N_BIAS_HEADS = 16
EPS = 1e-6
N_LAYERS_A = (DEPTH + 1) // 2
N_LAYERS_B = DEPTH // 2

kernel_name = "hybrid_dilated_diffattn_trunk"


def rmsnorm(x, g):
    xf = x.astype(jnp.float32)
    y = xf * lax.rsqrt(jnp.mean(xf * xf, axis=-1, keepdims=True) + EPS)
    return (y * g.astype(jnp.float32)).astype(x.dtype)


def rel_bucket(dist):
    n = jnp.maximum(dist, 0)
    max_exact = N_BUCKETS // 2
    nf = jnp.maximum(n, 1).astype(jnp.float32)
    large = max_exact + (jnp.log(nf / max_exact) / math.log(MAX_DISTANCE / max_exact)
                         * (N_BUCKETS - max_exact)).astype(jnp.int32)
    large = jnp.minimum(large, N_BUCKETS - 1)
    return jnp.where(n < max_exact, n, large)


def dilated_group_attention(q, k, v, window, dilation, rel_table):
    B, T, H, Dh = q.shape
    span = dilation * BLOCK
    Tp = -(-T // span) * span
    L = Tp // dilation
    nb = L // BLOCK
    sub_window = window // dilation

    def to_blocks(t):
        t = jnp.pad(t, ((0, 0), (0, Tp - T), (0, 0), (0, 0)))
        t = t.reshape(B, L, dilation, H, Dh).transpose(0, 2, 1, 3, 4)
        return t.reshape(B, dilation, nb, BLOCK, H, Dh)

    def with_prev(t):
        prev = jnp.pad(t, ((0, 0), (0, 0), (1, 0), (0, 0), (0, 0), (0, 0)))[:, :, :-1]
        return jnp.concatenate([prev, t], axis=3)

    qb = to_blocks(q)
    kw = with_prev(to_blocks(k))
    vw = with_prev(to_blocks(v))

    logits = jnp.einsum('bdnqhe,bdnkhe->bdnhqk', qb, kw,
                        preferred_element_type=jnp.float32) * (Dh ** -0.5)
    qi = jnp.arange(BLOCK)[:, None]
    kj = jnp.arange(2 * BLOCK)[None, :]
    sub_dist = qi + BLOCK - kj
    band = (sub_dist >= 0) & (sub_dist <= sub_window)
    not_first = (jnp.arange(nb) > 0)[:, None, None]
    valid = band[None] & (not_first | (kj >= BLOCK)[None])
    bias = rel_table[rel_bucket(sub_dist * dilation)]
    logits = logits + bias.transpose(2, 0, 1).astype(jnp.float32)[None, None, None]
    logits = jnp.where(valid[None, None, :, None], logits, -jnp.inf)
    lse = jax.nn.logsumexp(logits, axis=-1)
    probs = jnp.exp(logits - lse[..., None])
    out = jnp.einsum('bdnhqk,bdnkhe->bdnqhe', probs.astype(v.dtype), vw)

    out = out.reshape(B, dilation, L, H, Dh).transpose(0, 2, 1, 3, 4).reshape(B, Tp, H, Dh)[:, :T]
    lse = lse.transpose(0, 1, 2, 4, 3).reshape(B, dilation, L, H)
    lse = lse.transpose(0, 2, 1, 3).reshape(B, Tp, H)[:, :T]
    return out, lse


def dilated_mixture_attention(h, w_qkv, w_o, rel_table):
    B, T, _ = h.shape
    qkv = (h @ w_qkv).reshape(B, T, N_GROUPS_A, 3, HEADS_A, HEAD_DIM)
    outs, lses = [], []
    for g, (window, dilation) in enumerate(DIL_CONFIGS):
        o, l = dilated_group_attention(qkv[:, :, g, 0], qkv[:, :, g, 1], qkv[:, :, g, 2],
                                       window, dilation, rel_table)
        outs.append(o)
        lses.append(l)
    alpha = jax.nn.softmax(jnp.stack(lses, axis=0), axis=0)
    o = jnp.sum(alpha[..., None].astype(h.dtype) * jnp.stack(outs, axis=0), axis=0)
    return o.reshape(B, T, D_MODEL) @ w_o


def differential_attention(h, w_qkv, w_o, lq1, lk1, lq2, lk2, subln_g, rel_table, lambda_init):
    B, T, _ = h.shape
    q, k, v = jnp.split(h @ w_qkv, 3, axis=-1)
    q = q.reshape(B, T, HEADS_B, 2, HEAD_DIM)
    k = k.reshape(B, T, HEADS_B, 2, HEAD_DIM)
    v = v.reshape(B, T, HEADS_B, 2 * HEAD_DIM)
    lam = (jnp.exp(jnp.sum(lq1.astype(jnp.float32) * lk1.astype(jnp.float32)))
           - jnp.exp(jnp.sum(lq2.astype(jnp.float32) * lk2.astype(jnp.float32)))
           + lambda_init)
    nq = T // BLOCK
    qb = q.reshape(B, nq, BLOCK, HEADS_B, 2, HEAD_DIM).transpose(1, 0, 2, 3, 4, 5)
    starts = jnp.arange(nq, dtype=jnp.int32) * BLOCK
    kpos = jnp.arange(T, dtype=jnp.int32)
    table = rel_table.reshape(N_BUCKETS, HEADS_B, 2)
    scale = HEAD_DIM ** -0.5

    def one_block(args):
        qblk, start = args
        dist = (start + jnp.arange(BLOCK, dtype=jnp.int32))[:, None] - kpos[None, :]
        bias = table[rel_bucket(dist)].transpose(2, 3, 0, 1).astype(jnp.float32)
        logits = jnp.einsum('bqhje,bkhje->bhjqk', qblk, k,
                            preferred_element_type=jnp.float32) * scale + bias
        logits = jnp.where(dist >= 0, logits, -jnp.inf)
        probs = jax.nn.softmax(logits, axis=-1)
        attn = probs[:, :, 0] - lam * probs[:, :, 1]
        return jnp.einsum('bhqk,bkhe->bqhe', attn.astype(v.dtype), v)

    o = lax.map(one_block, (qb, starts))
    o = o.transpose(1, 0, 2, 3, 4).reshape(B, T, HEADS_B, 2 * HEAD_DIM)
    o = rmsnorm(o, subln_g) * (1.0 - lambda_init)
    return o.reshape(B, T, D_MODEL) @ w_o


def squared_relu_mlp(h, w1, w2):
    a = jax.nn.relu(h @ w1)
    return (a * a) @ w2


def setup_inputs(seed: int = 0) -> dict:
    key = jax.random.key(seed)
    ks = jax.random.split(key, 20)
    f32 = jnp.float32

    def w(k, shape, fan_in):
        return jax.random.normal(k, shape, f32) * fan_in ** -0.5

    def gain(k, shape):
        return 1.0 + 0.02 * jax.random.normal(k, shape, f32)

    return {
        "x": jax.random.normal(ks[0], (BATCH, SEQ, D_MODEL), f32),
        "p": jax.random.normal(ks[1], (DEPTH, BATCH, SEQ, PLE_DIM), f32),
        "rel_bias": 0.5 * jax.random.normal(ks[2], (N_BUCKETS, N_BIAS_HEADS), f32),
        "a_w_qkv": w(ks[3], (N_LAYERS_A, D_MODEL, N_GROUPS_A * 3 * HEADS_A * HEAD_DIM), D_MODEL),
        "a_w_o": w(ks[4], (N_LAYERS_A, D_MODEL, D_MODEL), D_MODEL),
        "b_w_qkv": w(ks[5], (N_LAYERS_B, D_MODEL, 3 * D_MODEL), D_MODEL),
        "b_w_o": w(ks[6], (N_LAYERS_B, D_MODEL, D_MODEL), D_MODEL),
        "b_lambda_q1": 0.1 * jax.random.normal(ks[7], (N_LAYERS_B, HEAD_DIM), f32),
        "b_lambda_k1": 0.1 * jax.random.normal(ks[8], (N_LAYERS_B, HEAD_DIM), f32),
        "b_lambda_q2": 0.1 * jax.random.normal(ks[9], (N_LAYERS_B, HEAD_DIM), f32),
        "b_lambda_k2": 0.1 * jax.random.normal(ks[10], (N_LAYERS_B, HEAD_DIM), f32),
        "b_subln": gain(ks[11], (N_LAYERS_B, 2 * HEAD_DIM)),
        "norm_mix": gain(ks[12], (DEPTH, D_MODEL)),
        "norm_mlp": gain(ks[13], (DEPTH, D_MODEL)),
        "w_ff1": w(ks[14], (DEPTH, D_MODEL, D_FF), D_MODEL),
        "w_ff2": w(ks[15], (DEPTH, D_FF, D_MODEL), D_FF),
        "norm_ple": gain(ks[16], (DEPTH, D_MODEL)),
        "w_ple_gate": w(ks[17], (DEPTH, D_MODEL, D_MODEL), D_MODEL),
        "w_ple_proj": w(ks[18], (DEPTH, PLE_DIM, D_MODEL), PLE_DIM),
        "final_norm": gain(ks[19], (D_MODEL,)),
    }


def reference(x, p, rel_bias, a_w_qkv, a_w_o, b_w_qkv, b_w_o, b_lambda_q1, b_lambda_k1,
              b_lambda_q2, b_lambda_k2, b_subln, norm_mix, norm_mlp, w_ff1, w_ff2,
              norm_ple, w_ple_gate, w_ple_proj, final_norm):
    h = x
    for i in range(DEPTH):
        hn = rmsnorm(h, norm_mix[i])
        j = i // N_MIXERS
        if i % N_MIXERS == 0:
            mix = dilated_mixture_attention(hn, a_w_qkv[j], a_w_o[j], rel_bias)
        else:
            lambda_init = 0.8 - 0.6 * math.exp(-0.3 * i)
            mix = differential_attention(hn, b_w_qkv[j], b_w_o[j], b_lambda_q1[j], b_lambda_k1[j],
                                         b_lambda_q2[j], b_lambda_k2[j], b_subln[j], rel_bias,
                                         lambda_init)
        h = h + mix
        h = h + squared_relu_mlp(rmsnorm(h, norm_mlp[i]), w_ff1[i], w_ff2[i])
        gate = jax.nn.sigmoid(rmsnorm(h, norm_ple[i]) @ w_ple_gate[i])
        h = h + gate * (p[i] @ w_ple_proj[i])
    return rmsnorm(h, final_norm)
```

```cpp
#include <hip/hip_runtime.h>
#include <cstdio>
#include <cstdint>

constexpr int BATCH = 2, T = 8192, D = 1024, M = BATCH * T, FF = 4096, PLE = 256;
constexpr int NQKV_A = 9216, NQKV_B = 3072;
constexpr float EPS = 1e-6f;
constexpr float LOG2E = 1.4426950408889634f;
constexpr float C2 = 0.125f * LOG2E;
constexpr int NWAVES_C = 8;
constexpr int GBT_N = 2048;

typedef unsigned short bf16;
typedef short bf16x8 __attribute__((ext_vector_type(8)));
typedef float f32x4 __attribute__((ext_vector_type(4)));
typedef unsigned v4u __attribute__((ext_vector_type(4)));
typedef unsigned v2u __attribute__((ext_vector_type(2)));
#define LAS __attribute__((address_space(3)))
#define GAS __attribute__((address_space(1)))

constexpr size_t MiB = 1u << 20;
constexpr size_t WS_CTL = 0, CTL_ZERO_BYTES = 1 * MiB;
constexpr size_t WS_GBT = 1 * MiB;
constexpr size_t WS_SSQ = 1 * MiB + 256 * 1024;
constexpr size_t SSQ_STRIDE = 256 * 1024;
constexpr size_t WS_LSE = 3 * MiB;
constexpr size_t WS_WA_QKV = 4 * MiB, WS_WA_O = 22 * MiB, WS_WB_QKV = 24 * MiB, WS_WB_O = 30 * MiB;
constexpr size_t WS_W1 = 32 * MiB, WS_W2 = 48 * MiB, WS_WG = 64 * MiB, WS_WP = 68 * MiB;
constexpr size_t WS_PB = 69 * MiB;
constexpr size_t WS_XA = 85 * MiB;
constexpr size_t WS_BIG = 128 * MiB;
constexpr size_t WS_QK = WS_BIG, WS_VT = WS_BIG + 64 * MiB, WS_MIX = WS_BIG + 96 * MiB;
constexpr size_t WS_QB = WS_BIG, WS_KB = WS_BIG + 32 * MiB, WS_VB = WS_BIG + 64 * MiB;
constexpr size_t WS_H = WS_BIG;
constexpr size_t WS_PROJ = WS_BIG;
constexpr size_t WS_END = 256 * MiB;

__device__ __forceinline__ unsigned f2bf(float f) { unsigned u = __builtin_bit_cast(unsigned, f); return (u + 0x7fffu + ((u >> 16) & 1u)) >> 16; }
__device__ __forceinline__ unsigned pk2(float lo, float hi) { return f2bf(lo) | (f2bf(hi) << 16); }
__device__ __forceinline__ float bf2f(unsigned short b) { return __builtin_bit_cast(float, (unsigned)b << 16); }
__device__ __forceinline__ float bflo(unsigned w) { return __builtin_bit_cast(float, w << 16); }
__device__ __forceinline__ float bfhi(unsigned w) { return __builtin_bit_cast(float, w & 0xffff0000u); }
__device__ __forceinline__ float wave_sum(float v) {
#pragma unroll
    for (int o = 1; o < 64; o <<= 1) v += __shfl_xor(v, o);
    return v;
}
__device__ __forceinline__ float wave_max(float v) {
#pragma unroll
    for (int o = 1; o < 64; o <<= 1) v = fmaxf(v, __shfl_xor(v, o));
    return v;
}
__device__ __forceinline__ int perm_to_token(int pos, int dil) {
    if (dil == 1) return pos;
    const int L = T / dil; const int b = pos / T, rem = pos % T, r = rem / L, s = rem % L; return b * T + s * dil + r;
}
__device__ __forceinline__ f32x4 ssq_raw(const float* ssq, int token) { return *(const f32x4*)(ssq + (size_t)token * 4); }
__device__ __forceinline__ float rstd_from(const f32x4 v) { return __builtin_amdgcn_rsqf(((v.x + v.y) + (v.z + v.w)) * (1.0f / D) + EPS); }
#define RAW8_FENCE(raw) asm volatile("" : "+v"(raw[0][0]), "+v"(raw[0][1]), "+v"(raw[0][2]), "+v"(raw[0][3]), "+v"(raw[1][0]), "+v"(raw[1][1]), "+v"(raw[1][2]), "+v"(raw[1][3]))
__device__ __forceinline__ float rstd_of(const float* ssq, int token) {
    const f32x4 v = *(const f32x4*)(ssq + (size_t)token * 4);
    return __builtin_amdgcn_rsqf(((v.x + v.y) + (v.z + v.w)) * (1.0f / D) + EPS);
}
__device__ __forceinline__ int rel_bucket(int n) {
    if (n < 16) return n;
    const float nf = (float)n;
    int large = 16 + (int)(logf(nf / 16.0f) / 4.852030263919617f * 16.0f);
    return large < 31 ? large : 31;
}

struct Args { const float* in[20]; float* out; unsigned char* ws; int ph_lo, ph_hi; };
__device__ __forceinline__ const float* karg_ptr(int byte_off) {
    GAS const float* p; auto ka = __builtin_amdgcn_kernarg_segment_ptr();
    asm volatile("s_load_dwordx2 %0, %1, %2\n\ts_waitcnt lgkmcnt(0)" : "=s"(p) : "s"(ka), "i"(byte_off) : "memory"); return (const float*)p;
}
#define AIN(i) karg_ptr(8 * (i))
#define AOUT ((float*)karg_ptr(160))
#define AWS ((unsigned char*)karg_ptr(168))

namespace pg8 {
#define PG8_LAS __attribute__((address_space(3)))
typedef unsigned short bf16_t;
typedef unsigned u32x4 __attribute__((ext_vector_type(4)));
constexpr int BM = 256, BK = 64, HALF = 128, HTB = HALF * BK * 2, STAGE_BYTES = 8 * HTB, NXCD = 8, WGM = 8;

__host__ __device__ __forceinline__ int lds_byte(int r, int c) { const int st = (r >> 4) * 2 + (c >> 5), rr = r & 15, cc = c & 31, ob = rr * 64 + cc * 2; return st * 1024 + (ob ^ (((ob >> 9) & 1) << 5)); }
__host__ __device__ __forceinline__ void stage_rc(int b, int& R, int& C) { const int st = b / 1024, sb = b % 1024, swz = sb ^ (((sb >> 9) & 1) << 5); R = (st >> 1) * 16 + swz / 64; C = (st & 1) * 32 + (swz % 64) / 2; }
__host__ __device__ __forceinline__ int perm32(int rho) { const int n = rho >> 4, i = rho & 15; return 8 * (i >> 2) + 4 * n + (i & 3); }

struct Unit { int pm, pn; };
struct Gemm { const bf16_t* A; const bf16_t* Bt; };

constexpr int GRID = 256;
template <int MR, int NC> struct StaticOrder {
    static constexpr int nM = MR / BM, nN = NC / BM, nwg = nM * nN;
    int c;
    __device__ __forceinline__ bool next(int i, Unit& u) const {
        const int L = i * GRID + c; if (L >= nwg) return false;
        int wgid = L; { constexpr int q = nwg / NXCD, r = nwg % NXCD; const int xcd = wgid % NXCD, off = wgid / NXCD; wgid = (xcd < r ? xcd * (q + 1) : r * (q + 1) + (xcd - r) * q) + off; }
        constexpr int nig = WGM * nN; const int gid = wgid / nig, fm = gid * WGM, gsz = (nM - fm) < WGM ? (nM - fm) : WGM;
        u.pm = fm + ((wgid % nig) % gsz); u.pn = (wgid % nig) / gsz; return true;
    }
};

typedef float f32x2_c __attribute__((ext_vector_type(2))); typedef __bf16 bf16x2_c __attribute__((ext_vector_type(2)));
__device__ __forceinline__ unsigned cvt_pk_bf16(float lo, float hi) { f32x2_c v = {lo, hi}; bf16x2_c b = __builtin_convertvector(v, bf16x2_c); return __builtin_bit_cast(unsigned, b); }

struct EpiRowScale {
    static constexpr bool PERM = true, AFTER_DRAIN = false, ROWSTAT = true; static constexpr int EPI_STORES = 16;
    bf16_t* O; int ldc; const float* ssq; int dil; int split; size_t split_stride; float scale0; int relu2; int kblk;
    __device__ __forceinline__ void preload(PG8_LAS float* sp, const Unit& u, int tid) const {
        if (ssq && tid < BM) sp[tid] = rstd_of(ssq, perm_to_token(u.pm * BM + tid, dil));
    }
    __device__ __forceinline__ void operator()(const f32x4 (&acc)[2][2][4][2], const Unit& u, int wr, int wc, int fr, int fq, const PG8_LAS float* sp) const {
        const int row0 = u.pm * BM + wr * 64 + fr; int colt = u.pn * BM; bf16_t* base = O;
        float sc = 1.f; bool kb = false; { const int t = colt >> 10; if (t == 0) sc = scale0; if (split) { base += (size_t)t * split_stride; colt -= t << 10; } kb = kblk != 0; }
        const int col0 = colt + wc * 32 + 8 * fq;
        float rsv[2][4];
#pragma unroll
        for (int ai = 0; ai < 2; ++ai)
#pragma unroll
            for (int m = 0; m < 4; ++m) rsv[ai][m] = ssq ? sp[wr * 64 + fr + ai * HALF + m * 16] * sc : sc;
#pragma unroll
        for (int ai = 0; ai < 2; ++ai)
#pragma unroll
            for (int m = 0; m < 4; ++m) { const int row = row0 + ai * HALF + m * 16; const float rs = rsv[ai][m];
                bf16_t* rowp = kb ? base + (((size_t)(row >> 5) * 16) * 8 * 32 + (row & 31)) * 8 : base + (size_t)row * ldc + col0;
#pragma unroll
                for (int bj = 0; bj < 2; ++bj) { f32x4 v0 = acc[ai][bj][m][0] * rs, v1 = acc[ai][bj][m][1] * rs;
                    if (relu2) { v0 = __builtin_elementwise_max(v0, (f32x4){0.f, 0.f, 0.f, 0.f}); v1 = __builtin_elementwise_max(v1, (f32x4){0.f, 0.f, 0.f, 0.f}); v0 = v0 * v0; v1 = v1 * v1; }
                    u32x4 w; w.x = cvt_pk_bf16(v0[0], v0[1]); w.y = cvt_pk_bf16(v0[2], v0[3]); w.z = cvt_pk_bf16(v1[0], v1[1]); w.w = cvt_pk_bf16(v1[2], v1[3]);
                    if (kb) { const int c8 = (col0 + bj * HALF) >> 3; *(u32x4*)(rowp + (size_t)c8 * 256) = w; }
                    else *(u32x4*)(rowp + bj * HALF) = w; } }
    }
};
struct EpiVT {
    static constexpr bool PERM = true, AFTER_DRAIN = false, ROWSTAT = true; static constexpr int EPI_STORES = 32;
    bf16_t* O; int ldc; const float* ssq; int dil;
    __device__ __forceinline__ void preload(PG8_LAS float* sp, const Unit& u, int tid) const {
        if (tid < BM) sp[tid] = rstd_of(ssq, perm_to_token(u.pn * BM + tid, dil));
    }
    __device__ __forceinline__ void operator()(const f32x4 (&acc)[2][2][4][2], const Unit& u, int wr, int wc, int fr, int fq, const PG8_LAS float* sp) const {
        const int row0 = u.pm * BM + wr * 64 + fr, col0 = u.pn * BM + wc * 32 + 8 * fq;
        f32x4 cs[2][2];
#pragma unroll
        for (int bj = 0; bj < 2; ++bj)
#pragma unroll
            for (int n = 0; n < 2; ++n) cs[bj][n] = *(const PG8_LAS f32x4*)(sp + wc * 32 + 8 * fq + bj * HALF + 4 * n);
#pragma unroll
        for (int ai = 0; ai < 2; ++ai)
#pragma unroll
            for (int m = 0; m < 4; ++m) {
                const int dg = row0 + ai * HALF + m * 16; const int head = dg >> 6, half = (dg >> 5) & 1, d31 = dg & 31;
#pragma unroll
                for (int bj = 0; bj < 2; ++bj) { const f32x4 v0 = acc[ai][bj][m][0] * cs[bj][0], v1 = acc[ai][bj][m][1] * cs[bj][1];
                    const int p0 = col0 + bj * HALF; const int tile = p0 >> 5, ks = (p0 >> 4) & 1, jh = (p0 >> 3) & 1;
                    bf16_t* fp = O + ((((((size_t)tile * 16 + head) * 2 + ks) * 2 + half) * 2) * 32 + d31) * 8 + jh * 4;
                    v2u w0, w1; w0.x = cvt_pk_bf16(v0[0], v0[1]); w0.y = cvt_pk_bf16(v0[2], v0[3]); w1.x = cvt_pk_bf16(v1[0], v1[1]); w1.y = cvt_pk_bf16(v1[2], v1[3]);
                    *(v2u*)fp = w0; *(v2u*)(fp + 256) = w1; } }
    }
};
template <bool BASE32, bool FINAL>
struct EpiRes {
    static constexpr bool PERM = true, AFTER_DRAIN = true, ROWSTAT = false; static constexpr int EPI_STORES = 0;
    const void* base; bf16_t* hout; float* ssq_out; const float* ssq_in; const bf16_t* proj; float* out; const float* gfin; unsigned* flags;
    __device__ __forceinline__ void fused(f32x4 (&acc)[2][2][4][2], const Unit& u, int wr, int wc, int fr, int fq, PG8_LAS unsigned char* lds, int wid, int lane) const {
        const int col0 = u.pn * BM + wc * 32 + 8 * fq;
        PG8_LAS float* P = (PG8_LAS float*)lds;
#pragma unroll
        for (int ai = 0; ai < 2; ++ai) {
            u32x4 bw[4][2], pw[4][2]; f32x4 bf0[4][2], bf1[4][2], rsr[4]; float rsm[4];
#pragma unroll
            for (int m = 0; m < 4; ++m) { const int grow = u.pm * BM + ai * HALF + wr * 64 + m * 16 + fr; const size_t off = (size_t)grow * D + col0;
#pragma unroll
                for (int bj = 0; bj < 2; ++bj) {
                    if constexpr (BASE32) { const f32x4* bp = (const f32x4*)((const float*)base + off + bj * HALF); bf0[m][bj] = bp[0]; bf1[m][bj] = bp[1]; }
                    else bw[m][bj] = *(const u32x4*)((const bf16_t*)base + off + bj * HALF);
                    if (proj) pw[m][bj] = *(const u32x4*)(proj + off + bj * HALF); }
                rsr[m] = (f32x4){1.f, 1.f, 1.f, 1.f}; if (proj) rsr[m] = ssq_raw(ssq_in, grow); }
            if constexpr (BASE32) asm volatile("" : "+v"(bf0[0][0]), "+v"(bf0[1][0]), "+v"(bf0[2][0]), "+v"(bf0[3][0]), "+v"(bf1[0][1]), "+v"(bf1[1][1]), "+v"(bf1[2][1]), "+v"(bf1[3][1]));
            else asm volatile("" : "+v"(bw[0][0]), "+v"(bw[1][0]), "+v"(bw[2][0]), "+v"(bw[3][0]), "+v"(bw[0][1]), "+v"(bw[1][1]), "+v"(bw[2][1]), "+v"(bw[3][1]));
            if (proj) asm volatile("" : "+v"(pw[0][0]), "+v"(pw[1][0]), "+v"(pw[2][0]), "+v"(pw[3][0]), "+v"(pw[0][1]), "+v"(pw[1][1]), "+v"(pw[2][1]), "+v"(pw[3][1]), "+v"(rsr[0]), "+v"(rsr[1]), "+v"(rsr[2]), "+v"(rsr[3]));
#pragma unroll
            for (int m = 0; m < 4; ++m) rsm[m] = proj ? rstd_from(rsr[m]) : 0.f;
#pragma unroll
            for (int m = 0; m < 4; ++m) { const int r = ai * HALF + wr * 64 + m * 16 + fr; const int grow = u.pm * BM + r; const size_t off = (size_t)grow * D + col0;
                const float rs = rsm[m];
                float s = 0.f;
#pragma unroll
                for (int bj = 0; bj < 2; ++bj) { f32x4 b0, b1;
                    if constexpr (BASE32) { b0 = bf0[m][bj]; b1 = bf1[m][bj]; }
                    else { const u32x4 w = bw[m][bj]; b0 = (f32x4){bflo(w.x), bfhi(w.x), bflo(w.y), bfhi(w.y)}; b1 = (f32x4){bflo(w.z), bfhi(w.z), bflo(w.w), bfhi(w.w)}; }
                    f32x4 a0 = acc[ai][bj][m][0], a1 = acc[ai][bj][m][1];
                    if (proj) { const u32x4 pr = pw[m][bj];
                        a0[0] = __builtin_amdgcn_rcpf(1.0f + __expf(-a0[0] * rs)) * bflo(pr.x); a0[1] = __builtin_amdgcn_rcpf(1.0f + __expf(-a0[1] * rs)) * bfhi(pr.x);
                        a0[2] = __builtin_amdgcn_rcpf(1.0f + __expf(-a0[2] * rs)) * bflo(pr.y); a0[3] = __builtin_amdgcn_rcpf(1.0f + __expf(-a0[3] * rs)) * bfhi(pr.y);
                        a1[0] = __builtin_amdgcn_rcpf(1.0f + __expf(-a1[0] * rs)) * bflo(pr.z); a1[1] = __builtin_amdgcn_rcpf(1.0f + __expf(-a1[1] * rs)) * bfhi(pr.z);
                        a1[2] = __builtin_amdgcn_rcpf(1.0f + __expf(-a1[2] * rs)) * bflo(pr.w); a1[3] = __builtin_amdgcn_rcpf(1.0f + __expf(-a1[3] * rs)) * bfhi(pr.w); }
                    const f32x4 h0 = b0 + a0, h1 = b1 + a1;
                    s += ((h0[0] * h0[0] + h0[1] * h0[1]) + (h0[2] * h0[2] + h0[3] * h0[3])) + ((h1[0] * h1[0] + h1[1] * h1[1]) + (h1[2] * h1[2] + h1[3] * h1[3]));
                    if constexpr (FINAL) { acc[ai][bj][m][0] = h0; acc[ai][bj][m][1] = h1; }
                    else { u32x4 w; w.x = cvt_pk_bf16(h0[0], h0[1]); w.y = cvt_pk_bf16(h0[2], h0[3]); w.z = cvt_pk_bf16(h1[0], h1[1]); w.w = cvt_pk_bf16(h1[2], h1[3]);
                        *(u32x4*)(hout + off + bj * HALF) = w; } }
                s += __shfl_xor(s, 16); s += __shfl_xor(s, 32);
                if (fq == 0) P[r * 4 + wc] = s; }
            asm volatile("" ::: "memory");
        }
        asm volatile("s_waitcnt lgkmcnt(0)" ::: "memory"); __builtin_amdgcn_s_barrier(); asm volatile("" ::: "memory");
        const int tid = wid * 64 + lane;
        if (tid < 256) { const f32x4 p = *(const PG8_LAS f32x4*)(P + tid * 4); ssq_out[(size_t)(u.pm * BM + tid) * 4 + u.pn] = (p[0] + p[1]) + (p[2] + p[3]); }
        if constexpr (FINAL) {
            asm volatile("s_waitcnt vmcnt(0) lgkmcnt(0)" ::: "memory"); __builtin_amdgcn_s_barrier(); asm volatile("" ::: "memory");
            if (tid == 0) {
                unsigned* fl = flags + u.pm * 16;
                __builtin_amdgcn_fence(__ATOMIC_RELEASE, "agent");
                __hip_atomic_fetch_add(fl, 1u, __ATOMIC_RELAXED, __HIP_MEMORY_SCOPE_AGENT);
                unsigned sp = 0;
                while (__hip_atomic_load(fl, __ATOMIC_RELAXED, __HIP_MEMORY_SCOPE_AGENT) < 4u) { __builtin_amdgcn_s_sleep(1); if (++sp > (1u << 22)) break; }
                __builtin_amdgcn_fence(__ATOMIC_ACQUIRE, "agent");
            }
            asm volatile("s_waitcnt vmcnt(0) lgkmcnt(0)" ::: "memory"); __builtin_amdgcn_s_barrier(); asm volatile("" ::: "memory");
            f32x4 gv[2][2];
#pragma unroll
            for (int bj = 0; bj < 2; ++bj) { const f32x4* gp = (const f32x4*)(gfin + col0 + bj * HALF); gv[bj][0] = gp[0]; gv[bj][1] = gp[1]; }
            float rfin[2][4];
            { f32x4 raw[2][4];
#pragma unroll
              for (int ai = 0; ai < 2; ++ai)
#pragma unroll
                for (int m = 0; m < 4; ++m) raw[ai][m] = ssq_raw(ssq_out, u.pm * BM + ai * HALF + wr * 64 + m * 16 + fr);
              RAW8_FENCE(raw);
#pragma unroll
              for (int ai = 0; ai < 2; ++ai)
#pragma unroll
                for (int m = 0; m < 4; ++m) rfin[ai][m] = rstd_from(raw[ai][m]); }
#pragma unroll
            for (int ai = 0; ai < 2; ++ai)
#pragma unroll
                for (int m = 0; m < 4; ++m) { const int grow = u.pm * BM + ai * HALF + wr * 64 + m * 16 + fr; const float rs = rfin[ai][m];
                    f32x4* op = (f32x4*)(out + (size_t)grow * D + col0);
#pragma unroll
                    for (int bj = 0; bj < 2; ++bj) { op[bj * (HALF / 4)] = acc[ai][bj][m][0] * rs * gv[bj][0]; op[bj * (HALF / 4) + 1] = acc[ai][bj][m][1] * rs * gv[bj][1]; } }
        }
        asm volatile("s_waitcnt lgkmcnt(0)" ::: "memory"); __builtin_amdgcn_s_barrier(); asm volatile("" ::: "memory");
    }
};

__device__ __forceinline__ size_t tile_row0(int tile, int dil) { return (size_t)perm_to_token(tile * BM, dil); }

template <class Epi, bool ALIGN_EPI, int MR, int NC, int K, int LDA, int LDB, int DILA, int DILB>
__device__ __forceinline__ void gemm_phase(PG8_LAS unsigned char* lds, const Gemm g, const Epi& E) {
    StaticOrder<MR, NC> S; S.c = (int)blockIdx.x;
    int tid_ = threadIdx.x; asm volatile("" : "+v"(tid_));
    const int tid = tid_, wid = __builtin_amdgcn_readfirstlane(tid >> 6), lane = tid & 63, wr = wid >> 2, wc = wid & 3, fr = lane & 15, fq = lane >> 4;
    constexpr int nt = K / BK;
    constexpr int pitchA = LDA * DILA, pitchB = LDB * DILB;
    unsigned voffA[2], voffB[2];
#pragma unroll
    for (int i = 0; i < 2; ++i) { int R, C; stage_rc(tid * 16 + i * 8192, R, C); const int Rb = Epi::PERM ? ((R & ~31) + perm32(R & 31)) : R;
        voffA[i] = (unsigned)(R * pitchA + C) * 2u; voffB[i] = (unsigned)(Rb * pitchB + C) * 2u; }
    constexpr size_t kstep = (size_t)(BK * 2);
    constexpr size_t hstepA = (size_t)HALF * pitchA * 2, hstepB = (size_t)HALF * pitchB * 2;
    const unsigned ldsw = (unsigned)wid * 1024u;
    const int aoff = lds_byte(wr * 64 + fr, fq * 8), boff = lds_byte(wc * 32 + fr, fq * 8);
#define PG8_SA(b, h) (((b) * 2 + (h)) * HTB)
#define PG8_SB(b, h) ((4 + (b) * 2 + (h)) * HTB)
#define PG8_STAGE(bufoff, gbase, voff) do { _Pragma("unroll") for (int _i = 0; _i < 2; ++_i) \
        __builtin_amdgcn_global_load_lds((const unsigned*)((const char*)(gbase) + (voff)[_i]), (PG8_LAS unsigned*)(lds + (bufoff) + ldsw + _i * 8192), 16, 0, 0); } while (0)
#define PG8_LDA(dst, b, h) do { _Pragma("unroll") for (int m = 0; m < 4; ++m) _Pragma("unroll") for (int k = 0; k < 2; ++k) dst[m][k] = *(const PG8_LAS bf16x8*)(lds + PG8_SA(b, h) + aoff + m * 2048 + k * 1024); } while (0)
#define PG8_LDB(dst, b, h) do { _Pragma("unroll") for (int n = 0; n < 2; ++n) _Pragma("unroll") for (int k = 0; k < 2; ++k) dst[n][k] = *(const PG8_LAS bf16x8*)(lds + PG8_SB(b, h) + boff + n * 2048 + k * 1024); } while (0)
#define PG8_MMA(ai, bj, At, Bt) do { __builtin_amdgcn_s_setprio(1); _Pragma("unroll") for (int m = 0; m < 4; ++m) _Pragma("unroll") for (int n = 0; n < 2; ++n) _Pragma("unroll") for (int k = 0; k < 2; ++k) \
        acc[ai][bj][m][n] = __builtin_amdgcn_mfma_f32_16x16x32_bf16(Bt[n][k], At[m][k], acc[ai][bj][m][n], 0, 0, 0); __builtin_amdgcn_s_setprio(0); } while (0)
#define PG8_WAIT_V(n) asm volatile("s_waitcnt vmcnt(" #n ")" ::: "memory")
#define PG8_WAIT_L(n) asm volatile("s_waitcnt lgkmcnt(" #n ")" ::: "memory")
#define PG8_BAR __builtin_amdgcn_s_barrier()
#define PG8_SCHED __builtin_amdgcn_sched_barrier(0)
#define PG8_ABASE(u) ((const char*)g.A + tile_row0((u).pm, DILA) * (size_t)LDA * 2)
#define PG8_BBASE(u) ((const char*)g.Bt + tile_row0((u).pn, DILB) * (size_t)LDB * 2)
    Unit cur, nxt; int ui = 0;
    if (!S.next(0, cur)) return;
    f32x4 acc[2][2][4][2];
#pragma unroll
    for (int a = 0; a < 2; ++a)
#pragma unroll
        for (int b = 0; b < 2; ++b)
#pragma unroll
            for (int m = 0; m < 4; ++m)
#pragma unroll
                for (int n = 0; n < 2; ++n) { acc[a][b][m][n] = (f32x4){0.f, 0.f, 0.f, 0.f}; asm volatile("" : "+v"(acc[a][b][m][n])); }
    bf16x8 At[4][2], B0[2][2], B1[2][2];
    const char* cA = PG8_ABASE(cur); const char* cB = PG8_BBASE(cur);
    PG8_STAGE(PG8_SB(0, 0), cB, voffB); PG8_STAGE(PG8_SB(0, 1), cB + hstepB, voffB); PG8_STAGE(PG8_SA(0, 0), cA, voffA); PG8_STAGE(PG8_SA(0, 1), cA + hstepA, voffA);
    PG8_LAS float* const sp = (PG8_LAS float*)(lds + STAGE_BYTES + 4096);
    if constexpr (Epi::ROWSTAT) E.preload(sp, cur, tid);
    if (wr == 1) PG8_BAR;
    PG8_WAIT_V(2); PG8_BAR;
    PG8_STAGE(PG8_SB(1, 0), cB + kstep, voffB); PG8_STAGE(PG8_SA(1, 0), cA + kstep, voffA); PG8_STAGE(PG8_SB(1, 1), cB + hstepB + kstep, voffB);
    PG8_WAIT_V(6); PG8_BAR;
#pragma unroll 1
    for (;;) {
        const bool has_next = S.next(ui + 1, nxt);
        const char* nA = has_next ? PG8_ABASE(nxt) : cA; const char* nB = has_next ? PG8_BBASE(nxt) : cB;
#pragma unroll 1
        for (int t = 0; t < nt; t += 2) {
            const bool last = (t == nt - 2);
            const char* a1 = cA + (size_t)(t + 1) * kstep;
            const char* a2 = last ? nA : cA + (size_t)(t + 2) * kstep; const char* b2 = last ? nB : cB + (size_t)(t + 2) * kstep;
            const char* a3 = a2 + kstep; const char* b3 = b2 + kstep;
            const bool lenient = !Epi::AFTER_DRAIN && Epi::EPI_STORES == 16 && t == 0 && ui > 0;
            PG8_LDB(B0, 0, 0); PG8_LDB(B1, 0, 1); PG8_SCHED; PG8_LDA(At, 0, 0); PG8_STAGE(PG8_SA(1, 1), a1 + hstepA, voffA);
            if (lenient) PG8_WAIT_V(24); else PG8_WAIT_V(8);
            PG8_WAIT_L(0); PG8_BAR; PG8_MMA(0, 0, At, B0); PG8_MMA(0, 1, At, B1); PG8_BAR; PG8_SCHED;
            PG8_LDA(At, 0, 1); PG8_STAGE(PG8_SB(0, 0), b2, voffB); PG8_STAGE(PG8_SB(0, 1), b2 + hstepB, voffB); PG8_STAGE(PG8_SA(0, 0), a2, voffA);
            if (lenient) PG8_WAIT_V(24); else PG8_WAIT_V(8);
            PG8_WAIT_L(0); PG8_BAR; PG8_MMA(1, 0, At, B0); PG8_MMA(1, 1, At, B1); PG8_BAR; PG8_SCHED;
            PG8_LDB(B0, 1, 0); PG8_LDB(B1, 1, 1); PG8_SCHED; PG8_LDA(At, 1, 0); PG8_STAGE(PG8_SA(0, 1), a2 + hstepA, voffA);
            PG8_WAIT_V(8); PG8_WAIT_L(0); PG8_BAR; PG8_MMA(0, 0, At, B0); PG8_MMA(0, 1, At, B1); PG8_BAR; PG8_SCHED;
            PG8_LDA(At, 1, 1); PG8_STAGE(PG8_SB(1, 0), b3, voffB); PG8_STAGE(PG8_SB(1, 1), b3 + hstepB, voffB); PG8_STAGE(PG8_SA(1, 0), a3, voffA);
            PG8_WAIT_V(8); PG8_WAIT_L(0); PG8_BAR; PG8_MMA(1, 0, At, B0); PG8_MMA(1, 1, At, B1); PG8_BAR; PG8_SCHED;
        }
        if constexpr (ALIGN_EPI) { if (wr == 0) PG8_BAR; }
        if constexpr (!Epi::AFTER_DRAIN) { E(acc, cur, wr, wc, fr, fq, sp); }
        if (!has_next) break;
#pragma unroll
        for (int a = 0; a < 2; ++a)
#pragma unroll
            for (int b = 0; b < 2; ++b)
#pragma unroll
                for (int m = 0; m < 4; ++m)
#pragma unroll
                    for (int n = 0; n < 2; ++n) { acc[a][b][m][n] = (f32x4){0.f, 0.f, 0.f, 0.f}; asm volatile("" : "+v"(acc[a][b][m][n])); }
        cur = nxt; cA = nA; cB = nB; ++ui;
        if constexpr (ALIGN_EPI) { if (wr == 1) PG8_BAR; }
    }
    PG8_WAIT_V(0);
    if constexpr (!ALIGN_EPI) { if (wr == 0) PG8_BAR; }
    PG8_BAR;
    if constexpr (Epi::AFTER_DRAIN) { E.fused(acc, cur, wr, wc, fr, fq, lds, wid, lane); }
#undef PG8_SA
#undef PG8_SB
#undef PG8_STAGE
#undef PG8_LDA
#undef PG8_LDB
#undef PG8_MMA
#undef PG8_WAIT_V
#undef PG8_WAIT_L
#undef PG8_BAR
#undef PG8_SCHED
#undef PG8_ABASE
#undef PG8_BBASE
}
}


#include <hip/hip_bf16.h>
namespace att {
using bf16h = __hip_bfloat16;
using s16x4 = __attribute__((ext_vector_type(4))) short;
using f32x16 = __attribute__((ext_vector_type(16))) float;
using u32x4 = __attribute__((ext_vector_type(4))) unsigned;
constexpr int DM = 1024, NW = 8, QBLK = 32, QB = QBLK * NW, KVBLK = 64;
constexpr int NSLOT = 3, SLOTB = 8192;
constexpr int LDS_K = 0, LDS_V = NSLOT * SLOTB, LDS_WS = 2 * NSLOT * SLOTB, LDS_OST = LDS_WS + NW * 64 * 4;
constexpr int GUARD = 256;
constexpr float MASKV = -__builtin_huge_valf();
template <int MODE> struct Geo {
    static constexpr int OST_BYTES = MODE == 0 ? NW * 4096 : NW * 8192;
    static constexpr int LDS_TBL = LDS_OST + OST_BYTES;
    static constexpr int NTBL = MODE == 0 ? GUARD + 8192 : GUARD + 384;
    static constexpr int LDS_END = LDS_TBL + NTBL * 4;
};
static_assert(Geo<0>::LDS_END <= 131072 && Geo<1>::LDS_END <= 131072, "attention LDS map");
__device__ __forceinline__ int crow(int r, int hi) { return (r & 3) + 8 * (r >> 2) + 4 * hi; }
#define SBAR() __builtin_amdgcn_sched_barrier(0)
__device__ __forceinline__ void glds16(const void* gsrc, unsigned lds_dst) { unsigned keep;
    asm volatile("s_mov_b32 %0, m0\n\ts_mov_b32 m0, %2\n\ts_nop 0\n\tglobal_load_lds_dwordx4 %1, off\n\ts_mov_b32 m0, %0" : "=&s"(keep) : "v"(gsrc), "s"(lds_dst) : "memory"); }
__device__ __forceinline__ float max3f(float a, float b, float c) { float r; asm("v_max3_f32 %0, %1, %2, %3" : "=v"(r) : "v"(a), "v"(b), "v"(c)); return r; }
__device__ __forceinline__ float max2f(float a, float b) { float r; asm("v_max_f32_e32 %0, %1, %2" : "=v"(r) : "v"(a), "v"(b)); return r; }
__device__ __forceinline__ float fadd_s(float a, float b) { float r; asm("v_add_f32_e32 %0, %1, %2" : "=v"(r) : "v"(a), "v"(b)); return r; }
__device__ __forceinline__ float fsub_s(float a, float b) { float r; asm("v_sub_f32_e32 %0, %1, %2" : "=v"(r) : "v"(a), "v"(b)); return r; }
typedef float f32x2_t __attribute__((ext_vector_type(2))); typedef __bf16 bf16x2_t __attribute__((ext_vector_type(2)));
__device__ __forceinline__ unsigned cvtpk_s(float lo, float hi) { f32x2_t v = {lo, hi}; bf16x2_t b = __builtin_convertvector(v, bf16x2_t); return __builtin_bit_cast(unsigned, b); }
#define WAIT_BAR(N) asm volatile("s_waitcnt vmcnt(" #N ") lgkmcnt(0)\n\ts_barrier" ::: "memory")
typedef __attribute__((address_space(3))) const char* lds_cptr;
typedef __attribute__((address_space(3))) char* lds_ptr;
#define ALDS __attribute__((address_space(3)))
typedef short v4i16_t __attribute__((ext_vector_type(4)));

__device__ __forceinline__ void qkt(f32x16& p0, f32x16& p1, lds_cptr Kslot, const bf16x8* qr, const f32x16& negm, int r32, int hi) {
    lds_cptr kb = Kslot + hi * 1024 + r32 * 16;
#pragma unroll
    for (int d0 = 0; d0 < 4; ++d0) {
        const bf16x8 b0 = *(const ALDS bf16x8*)(kb + d0 * 2048);
        const bf16x8 b1 = *(const ALDS bf16x8*)(kb + d0 * 2048 + 512);
        if (d0 == 0) { p0 = __builtin_amdgcn_mfma_f32_32x32x16_bf16(b0, qr[0], negm, 0, 0, 0); p1 = __builtin_amdgcn_mfma_f32_32x32x16_bf16(b1, qr[0], negm, 0, 0, 0); }
        else { p0 = __builtin_amdgcn_mfma_f32_32x32x16_bf16(b0, qr[d0], p0, 0, 0, 0); p1 = __builtin_amdgcn_mfma_f32_32x32x16_bf16(b1, qr[d0], p1, 0, 0, 0); } }
}
__device__ __forceinline__ void kload8(bf16x8* kf, lds_cptr kp) {
    kf[0] = *(const __attribute__((address_space(3))) bf16x8*)(kp);        kf[1] = *(const __attribute__((address_space(3))) bf16x8*)(kp + 512);
    kf[2] = *(const __attribute__((address_space(3))) bf16x8*)(kp + 2048); kf[3] = *(const __attribute__((address_space(3))) bf16x8*)(kp + 2560);
    kf[4] = *(const __attribute__((address_space(3))) bf16x8*)(kp + 4096); kf[5] = *(const __attribute__((address_space(3))) bf16x8*)(kp + 4608);
    kf[6] = *(const __attribute__((address_space(3))) bf16x8*)(kp + 6144); kf[7] = *(const __attribute__((address_space(3))) bf16x8*)(kp + 6656);
}
__device__ __forceinline__ void kload2(bf16x8* kf, lds_cptr kp, int j) { kf[2 * j] = *(const __attribute__((address_space(3))) bf16x8*)(kp + j * 2048); kf[2 * j + 1] = *(const __attribute__((address_space(3))) bf16x8*)(kp + j * 2048 + 512); }
__device__ __forceinline__ s16x4 vtr(lds_cptr p) { return __builtin_bit_cast(s16x4, __builtin_amdgcn_ds_read_tr16_b64_v4i16((__attribute__((address_space(3))) v4i16_t*)p)); }
__device__ __forceinline__ float rowmax(const f32x16& p0, const f32x16& p1) {
    float a = max3f(p0[0], p0[1], p1[0]), b = max3f(p0[2], p0[3], p1[1]); a = max3f(a, p1[2], p1[3]);
#pragma unroll
    for (int r = 4; r < 16; r += 4) { a = max3f(a, p0[r], p0[r + 1]); b = max3f(b, p0[r + 2], p0[r + 3]); a = max3f(a, p1[r], p1[r + 1]); b = max3f(b, p1[r + 2], p1[r + 3]); }
    const float m = max2f(a, b);
    auto rr = __builtin_amdgcn_permlane32_swap(__float_as_uint(m), __float_as_uint(m), false, false);
    return max2f(__uint_as_float(rr[0]), __uint_as_float(rr[1]));
}
__device__ __forceinline__ void pv(f32x16* o, int vb, bf16x8 pa0, bf16x8 pa1, bf16x8 pa2, bf16x8 pa3) {
#pragma unroll
    for (int d0 = 0; d0 < 2; ++d0) { s16x4 lo[4], hi[4];
#pragma unroll
        for (int ks = 0; ks < 4; ++ks) {
            asm volatile("ds_read_b64_tr_b16 %0,%1 offset:%c2" : "=&v"(lo[ks]) : "v"(vb), "i"(d0 * 4096 + ks * 1024) : "memory");
            asm volatile("ds_read_b64_tr_b16 %0,%1 offset:%c2" : "=&v"(hi[ks]) : "v"(vb), "i"(d0 * 4096 + ks * 1024 + 512) : "memory"); }
        asm volatile("s_waitcnt lgkmcnt(0)" ::: "memory"); SBAR();
#define PK(k) (bf16x8){lo[k][0], lo[k][1], lo[k][2], lo[k][3], hi[k][0], hi[k][1], hi[k][2], hi[k][3]}
        o[d0] = __builtin_amdgcn_mfma_f32_32x32x16_bf16(pa0, PK(0), o[d0], 0, 0, 0);
        o[d0] = __builtin_amdgcn_mfma_f32_32x32x16_bf16(pa1, PK(1), o[d0], 0, 0, 0);
        o[d0] = __builtin_amdgcn_mfma_f32_32x32x16_bf16(pa2, PK(2), o[d0], 0, 0, 0);
        o[d0] = __builtin_amdgcn_mfma_f32_32x32x16_bf16(pa3, PK(3), o[d0], 0, 0, 0);
#undef PK
    }
}

struct UnitDesc {
    const bf16h* Q; const bf16h* K; const bf16h* V;
    int q0, kt0, NT;
    int NT_far; float cfar; int tbl_off;
    int comb;
    bf16h* O;
    bf16h* MIXp; float* LSEp; int tok0, dil, g;
};

template <int MODE, int THRL> __device__ __forceinline__ void attn_unit(const UnitDesc& U, lds_ptr shm) {
    int tid_ = threadIdx.x; asm volatile("" : "+v"(tid_));
    const int tid = tid_, lane = tid & 63, r32 = lane & 31, hi = lane >> 5; const int wid = __builtin_amdgcn_readfirstlane(tid >> 6);
    const int q0 = U.q0;
    const bf16h* Qw = U.Q + (long)(q0 + wid * QBLK) * DM;
    const bf16h* Kh = U.K + (long)U.kt0 * KVBLK * DM; const bf16h* Vh = U.V + (long)U.kt0 * KVBLK * DM;
    const unsigned lds0 = (unsigned)(uintptr_t)shm;
    ALDS float* wsf = (ALDS float*)(shm + LDS_WS) + wid * 64;
    const bf16h* ksrc = Kh + (long)lane * DM + wid * 8;
    const bf16h* vsrc = Vh + (long)(16 * (wid & 3) + (lane >> 2)) * DM + (wid >> 2) * 32 + (lane & 3) * 8;
    const unsigned kdst = lds0 + LDS_K + wid * 1024, vdst = lds0 + LDS_V + wid * 1024;
#define DMA_K(t, slot) glds16(ksrc + (long)(t) * KVBLK * DM, (unsigned)__builtin_amdgcn_readfirstlane(kdst + (slot)))
#define DMA_V(t, slot) glds16(vsrc + (long)(t) * KVBLK * DM, (unsigned)__builtin_amdgcn_readfirstlane(vdst + (slot)))
    const int vb0 = (int)(lds0 + LDS_V) + ((lane >> 4) & 1) * 32 + (lane & 3) * 8 + (4 * hi + ((lane & 15) >> 2)) * 64;
    const lds_cptr Kbase = shm + LDS_K; bf16x8 kf[8];
    const lds_cptr shm3 = (lds_cptr)shm; const lds_cptr kp0 = shm3 + LDS_K + hi * 1024 + r32 * 16; const lds_cptr vp0 = shm3 + LDS_V + ((lane >> 4) & 1) * 32 + (lane & 3) * 8 + (4 * hi + ((lane & 15) >> 2)) * 64;
    const lds_cptr tb0 = shm3 + Geo<MODE>::LDS_TBL + 4 * (GUARD - 59 + (q0 - KVBLK * U.kt0) + QBLK * wid + r32 - 4 * hi);
    const int NT = U.NT;
    DMA_K(0, 0); DMA_V(0, 0); DMA_K(1, SLOTB);
    bf16x8 qr[4];
#pragma unroll
    for (int d0 = 0; d0 < 4; ++d0) qr[d0] = *reinterpret_cast<const bf16x8*>(&Qw[(long)r32 * DM + d0 * 16 + hi * 8]);
    float mhat = 0.f, l_reg = 0.f; f32x16 o[2]; o[0] = f32x16{}; o[1] = f32x16{}; asm volatile("" : "+v"(o[0]), "+v"(o[1]));
    const int NT_far = U.NT_far; float cb = NT_far > 0 ? U.cfar : 0.f;
    f32x16 negm; _Pragma("unroll") for (int r = 0; r < 16; ++r) negm[r] = cb; asm volatile("" : "+v"(negm));
#define BIAS(P0, P1, T0, T1, t) do { const ALDS float* tb_ = (const ALDS float*)(tb0 - 256 * (t)); \
    _Pragma("unroll") for (int r = 0; r < 16; ++r) T0[r] = tb_[59 - ((r & 3) + 8 * (r >> 2))]; \
    asm volatile("s_waitcnt lgkmcnt(0)" : "+v"(T0) :: "memory"); \
    _Pragma("unroll") for (int r = 0; r < 16; ++r) P0[r] += T0[r]; \
    _Pragma("unroll") for (int r = 0; r < 16; ++r) T0[r] = tb_[27 - ((r & 3) + 8 * (r >> 2))]; \
    asm volatile("s_waitcnt lgkmcnt(0)" : "+v"(T0) :: "memory"); \
    _Pragma("unroll") for (int r = 0; r < 16; ++r) P1[r] += T0[r]; } while (0)
    bool resc = false;
#define START(P0, P1) do { const float rm = rowmax(P0, P1); resc = false; \
    { const float dl = rm < -1e30f ? 0.f : rm; mhat = fadd_s(mhat, dl); \
      _Pragma("unroll") for (int r = 0; r < 16; ++r) { P0[r] = fsub_s(P0[r], dl); P1[r] = fsub_s(P1[r], dl); } \
      _Pragma("unroll") for (int r = 0; r < 16; ++r) negm[r] = cb - mhat; asm volatile("" : "+v"(negm)); } \
    _Pragma("unroll") for (int r = 0; r < 16; ++r) P0[r] = __builtin_amdgcn_exp2f(P0[r]); } while (0)
#define RESC() do { if (resc) { asm volatile("s_waitcnt lgkmcnt(0)" ::: "memory"); \
      _Pragma("unroll") for (int d_ = 0; d_ < 2; ++d_) _Pragma("unroll") for (int r = 0; r < 16; ++r) o[d_][r] *= wsf[crow(r, hi)]; } } while (0)
    f32x16 pA0, pA1, pB0, pB1;
    int sl_prev = 0, sl_cur = 0, sl_next = SLOTB;
#define ROT() do { sl_prev = sl_cur; sl_cur = sl_next; sl_next = (sl_next == (NSLOT - 1) * SLOTB) ? 0 : sl_next + SLOTB; } while (0)
#define NEARCHK(tn) do { if ((tn) == NT_far) { cb = 0.f; _Pragma("unroll") for (int r = 0; r < 16; ++r) negm[r] = -mhat; asm volatile("" : "+v"(negm)); } } while (0)
    DMA_K(2, 2 * SLOTB);
    WAIT_BAR(3);
    qkt(pA0, pA1, Kbase, qr, negm, r32, hi); asm volatile("s_nop 15\n\ts_nop 7" : "+v"(pA0), "+v"(pA1)); if (NT_far == 0) BIAS(pA0, pA1, pB0, pB1, 0);
    START(pA0, pA1);
    _Pragma("unroll") for (int r = 0; r < 16; ++r) pA1[r] = __builtin_amdgcn_exp2f(pA1[r]);
    WAIT_BAR(0);
    DMA_K(3, 0); DMA_V(1, SLOTB);
    ROT(); NEARCHK(1);
    kload8(kf, kp0 + sl_cur);
    WAIT_BAR(2);
    s16x4 vlo[8], vhi[8]; u32x4 pw0, pw1, pw2, pw3;
#define PKW(P, B) cvtpk_s(P[B], P[B + 1])
#define PAF(k) __builtin_bit_cast(bf16x8, pw##k)
#define VFR(i) (bf16x8){vlo[i][0], vlo[i][1], vlo[i][2], vlo[i][3], vhi[i][0], vhi[i][1], vhi[i][2], vhi[i][3]}
#define PIN(x) asm volatile("" : "+v"(x))
#define MX3(a, b, c) __builtin_fmaxf(__builtin_fmaxf((a), (b)), (c))
#define GAPA(MF, A0, A1, A2, A3, W0, W1, PW) do { MF; sacc += A0; sacc += A1; sacc += A2; sacc += A3; PIN(sacc); W0; W1; PIN(PW); SBAR(); } while (0)
#define EX(v) __builtin_amdgcn_exp2f(v)
#define GAPB(MF, X, B) do { MF; X[B] = EX(X[B]); X[B + 1] = EX(X[B + 1]); X[B + 2] = EX(X[B + 2]); X[B + 3] = EX(X[B + 3]); PIN(X); SBAR(); } while (0)
#define VRD(i) do { vlo[i] = vtr(vp_ + (((i) >> 2) * 4096 + ((i) & 3) * 1024)); vhi[i] = vtr(vp_ + (((i) >> 2) * 4096 + ((i) & 3) * 1024 + 512)); } while (0)
#define KRD(G, j) do { if (G) { kload2(kf, kp0 + sl_next, j); SBAR(); } } while (0)
#define STEP(C0, C1, P0, P1, t, GK, GV, GL) do { SBAR(); \
    const lds_cptr vp_ = vp0 + sl_prev; \
    VRD(0); SBAR(); float sacc = (P0[0] + P0[1]); \
    GAPA(C0 = __builtin_amdgcn_mfma_f32_32x32x16_bf16(kf[0], qr[0], negm, 0, 0, 0), P0[2], P0[3], P0[4], P0[5],     pw0[0] = PKW(P0, 0), pw0[1] = PKW(P0, 2), pw0); \
    VRD(4); SBAR(); GAPA(C1 = __builtin_amdgcn_mfma_f32_32x32x16_bf16(kf[1], qr[0], negm, 0, 0, 0), P0[6], P0[7], P0[8], P0[9],     pw0[2] = PKW(P0, 4), pw0[3] = PKW(P0, 6), pw0); \
    VRD(1); SBAR(); GAPA(C0 = __builtin_amdgcn_mfma_f32_32x32x16_bf16(kf[2], qr[1], C0, 0, 0, 0),   P0[10], P0[11], P0[12], P0[13], pw1[0] = PKW(P0, 8), pw1[1] = PKW(P0, 10), pw1); \
    VRD(5); SBAR(); GAPA(C1 = __builtin_amdgcn_mfma_f32_32x32x16_bf16(kf[3], qr[1], C1, 0, 0, 0),   P0[14], P0[15], P1[0], P1[1],   pw1[2] = PKW(P0, 12), pw1[3] = PKW(P0, 14), pw1); \
    VRD(2); SBAR(); GAPA(C0 = __builtin_amdgcn_mfma_f32_32x32x16_bf16(kf[4], qr[2], C0, 0, 0, 0),   P1[2], P1[3], P1[4], P1[5],     pw2[0] = PKW(P1, 0), pw2[1] = PKW(P1, 2), pw2); \
    VRD(6); SBAR(); GAPA(C1 = __builtin_amdgcn_mfma_f32_32x32x16_bf16(kf[5], qr[2], C1, 0, 0, 0),   P1[6], P1[7], P1[8], P1[9],     pw2[2] = PKW(P1, 4), pw2[3] = PKW(P1, 6), pw2); \
    VRD(3); SBAR(); GAPA(C0 = __builtin_amdgcn_mfma_f32_32x32x16_bf16(kf[6], qr[3], C0, 0, 0, 0),   P1[10], P1[11], P1[12], P1[13], pw3[0] = PKW(P1, 8), pw3[1] = PKW(P1, 10), pw3); \
    VRD(7); SBAR(); GAPA(C1 = __builtin_amdgcn_mfma_f32_32x32x16_bf16(kf[7], qr[3], C1, 0, 0, 0),   P1[14], P1[15], 0.f, 0.f,       pw3[2] = PKW(P1, 12), pw3[3] = PKW(P1, 14), pw3); \
    l_reg += sacc; \
    if (GK) { DMA_K((t) + 3, sl_cur); } if (GV) { DMA_V((t) + 1, sl_next); } \
    if ((t) >= NT_far) BIAS(C0, C1, P0, P1, t); \
    { float a = MX3(C0[0], C0[1], C1[0]), b = MX3(C0[2], C0[3], C1[1]); a = MX3(a, C1[2], C1[3]); \
      _Pragma("unroll") for (int r = 4; r < 16; r += 4) { a = MX3(a, C0[r], C0[r + 1]); b = MX3(b, C0[r + 2], C0[r + 3]); a = MX3(a, C1[r], C1[r + 1]); b = MX3(b, C1[r + 2], C1[r + 3]); } \
      float rm = __builtin_fmaxf(a, b); { auto rr = __builtin_amdgcn_permlane32_swap(__float_as_uint(rm), __float_as_uint(rm), false, false); rm = __builtin_fmaxf(__uint_as_float(rr[0]), __uint_as_float(rr[1])); } \
      resc = false; \
      if (__builtin_expect(__any(rm > (float)THRL), 0)) { const float dl = __builtin_fmaxf(rm, 0.f); mhat += dl; \
        _Pragma("unroll") for (int r = 0; r < 16; ++r) { C0[r] -= dl; C1[r] -= dl; } \
        _Pragma("unroll") for (int r = 0; r < 16; ++r) negm[r] = cb - mhat; asm volatile("" : "+v"(negm)); \
        const float f = __builtin_amdgcn_exp2f(-dl); l_reg *= f; if (hi == 0) wsf[r32] = f; resc = true; } } \
    SBAR(); \
    GAPB(o[0] = __builtin_amdgcn_mfma_f32_32x32x16_bf16(PAF(0), VFR(0), o[0], 0, 0, 0), C0, 0); \
    GAPB(o[1] = __builtin_amdgcn_mfma_f32_32x32x16_bf16(PAF(0), VFR(4), o[1], 0, 0, 0), C0, 4); \
    KRD(GL, 0); GAPB(o[0] = __builtin_amdgcn_mfma_f32_32x32x16_bf16(PAF(1), VFR(1), o[0], 0, 0, 0), C0, 8); \
    KRD(GL, 1); GAPB(o[1] = __builtin_amdgcn_mfma_f32_32x32x16_bf16(PAF(1), VFR(5), o[1], 0, 0, 0), C0, 12); \
    KRD(GL, 2); GAPB(o[0] = __builtin_amdgcn_mfma_f32_32x32x16_bf16(PAF(2), VFR(2), o[0], 0, 0, 0), C1, 0); \
    KRD(GL, 3); GAPB(o[1] = __builtin_amdgcn_mfma_f32_32x32x16_bf16(PAF(2), VFR(6), o[1], 0, 0, 0), C1, 4); \
    GAPB(o[0] = __builtin_amdgcn_mfma_f32_32x32x16_bf16(PAF(3), VFR(3), o[0], 0, 0, 0), C1, 8); \
    GAPB(o[1] = __builtin_amdgcn_mfma_f32_32x32x16_bf16(PAF(3), VFR(7), o[1], 0, 0, 0), C1, 12); \
    } while (0)
    int t = 1;
    for (; t + 5 < NT; t += 2) {
        STEP(pB0, pB1, pA0, pA1, t, true, true, true);     WAIT_BAR(2); RESC(); ROT(); NEARCHK(t + 1);
        STEP(pA0, pA1, pB0, pB1, t + 1, true, true, true); WAIT_BAR(2); RESC(); ROT(); NEARCHK(t + 2);
    }
#define ENDW(tt) do { if ((tt) + 3 < NT) { WAIT_BAR(2); } else if ((tt) + 2 < NT) { WAIT_BAR(1); } else { WAIT_BAR(0); } } while (0)
    for (; t + 1 < NT; t += 2) {
        STEP(pB0, pB1, pA0, pA1, t, (t + 3 < NT), (t + 1 < NT), (t + 1 < NT));         ENDW(t);     RESC(); ROT(); NEARCHK(t + 1);
        STEP(pA0, pA1, pB0, pB1, t + 1, (t + 4 < NT), (t + 2 < NT), (t + 2 < NT));     ENDW(t + 1); RESC(); ROT(); NEARCHK(t + 2);
    }
    STEP(pB0, pB1, pA0, pA1, NT - 1, false, false, false); RESC();
    { float sacc = pB0[0] + pB0[1]; _Pragma("unroll") for (int r = 2; r < 16; ++r) sacc += pB0[r]; _Pragma("unroll") for (int r = 0; r < 16; ++r) sacc += pB1[r]; l_reg += sacc;
      pw0 = (u32x4){PKW(pB0, 0), PKW(pB0, 2), PKW(pB0, 4), PKW(pB0, 6)}; pw1 = (u32x4){PKW(pB0, 8), PKW(pB0, 10), PKW(pB0, 12), PKW(pB0, 14)}; pw2 = (u32x4){PKW(pB1, 0), PKW(pB1, 2), PKW(pB1, 4), PKW(pB1, 6)}; pw3 = (u32x4){PKW(pB1, 8), PKW(pB1, 10), PKW(pB1, 12), PKW(pB1, 14)};
      SBAR(); pv(o, vb0 + sl_cur, PAF(0), PAF(1), PAF(2), PAF(3)); }
#undef PKW
#undef PAF
#undef VFR
#undef PIN
#undef MX3
#undef GAPA
#undef GAPB
#undef EX
#undef VRD
#undef KRD
#undef STEP
#undef ENDW
    int tidE = threadIdx.x; asm volatile("" : "+v"(tidE)); const int laneE = tidE & 63, r32E = laneE & 31, hiE = laneE >> 5;
    { auto rr = __builtin_amdgcn_permlane32_swap(__float_as_uint(l_reg), __float_as_uint(l_reg), false, false); l_reg = __uint_as_float(rr[0]) + __uint_as_float(rr[1]); }
    if constexpr (MODE == 0) {
        if (hiE == 0) wsf[32 + r32E] = l_reg; asm volatile("s_waitcnt lgkmcnt(0)" ::: "memory");
        float rli[16];
#pragma unroll
        for (int r = 0; r < 16; ++r) rli[r] = __builtin_amdgcn_rcpf(wsf[32 + crow(r, hiE)]);
        bf16h* Ow = U.O + (long)(q0 + wid * QBLK) * DM;
        ALDS unsigned short* stg = (ALDS unsigned short*)(shm + LDS_OST) + wid * 2048;
#pragma unroll
        for (int r = 0; r < 16; ++r) { const int orow = crow(r, hiE);
#pragma unroll
            for (int d0 = 0; d0 < 2; ++d0) stg[orow * 64 + d0 * 32 + r32E] = __builtin_bit_cast(unsigned short, (__bf16)(o[d0][r] * rli[r])); }
        asm volatile("s_waitcnt lgkmcnt(0)" ::: "memory");
#pragma unroll
        for (int i = 0; i < 4; ++i) { const int row = i * 8 + (laneE >> 3), ch = laneE & 7; const u32x4 v = *(const ALDS u32x4*)(stg + row * 64 + ch * 8); *(u32x4*)(Ow + (long)row * DM + ch * 8) = v; }
    } else {
        const int srow = q0 + wid * QBLK + r32E; const long tok = (long)U.tok0 + (long)srow * U.dil;
        float lse_g = mhat + __builtin_amdgcn_logf(l_reg);
        float ca = 0.f, cg = __builtin_amdgcn_rcpf(l_reg), lse_new = lse_g;
        if (U.g > 0) { const float la = U.LSEp[tok * 16]; const float Mx = __builtin_fmaxf(la, lse_g); const float wa = __builtin_amdgcn_exp2f(la - Mx), wg = __builtin_amdgcn_exp2f(lse_g - Mx);
            const float inv = __builtin_amdgcn_rcpf(wa + wg); ca = wa * inv; cg = wg * inv * cg; lse_new = Mx + __builtin_amdgcn_logf(wa + wg); }
        if (hiE == 0) { wsf[r32E] = ca; wsf[32 + r32E] = cg; U.LSEp[tok * 16] = lse_new; }
        asm volatile("s_waitcnt lgkmcnt(0)" ::: "memory");
        ALDS float* stg = (ALDS float*)(shm + LDS_OST) + wid * 2048;
#pragma unroll
        for (int r = 0; r < 16; ++r) { const int orow = crow(r, hiE); const float sc = wsf[32 + orow];
#pragma unroll
            for (int d0 = 0; d0 < 2; ++d0) stg[orow * 64 + d0 * 32 + r32E] = o[d0][r] * sc; }
        asm volatile("s_waitcnt lgkmcnt(0)" ::: "memory");
#pragma unroll
        for (int i = 0; i < 4; ++i) { const int row = i * 8 + (laneE >> 3), ch = laneE & 7;
            const f32x4 a0 = *(const ALDS f32x4*)(stg + row * 64 + ch * 8), a1 = *(const ALDS f32x4*)(stg + row * 64 + ch * 8 + 4);
            bf16h* mp = U.MIXp + ((long)U.tok0 + (long)(q0 + wid * QBLK + row) * U.dil) * DM + ch * 8;
            f32x4 r0 = a0, r1 = a1;
            if (U.g > 0) { const float car = wsf[row]; const u32x4 pv_ = *(const u32x4*)mp;
                r0[0] += car * bflo(pv_.x); r0[1] += car * bfhi(pv_.x); r0[2] += car * bflo(pv_.y); r0[3] += car * bfhi(pv_.y);
                r1[0] += car * bflo(pv_.z); r1[1] += car * bfhi(pv_.z); r1[2] += car * bflo(pv_.w); r1[3] += car * bfhi(pv_.w); }
            u32x4 w; w.x = cvtpk_s(r0[0], r0[1]); w.y = cvtpk_s(r0[2], r0[3]); w.z = cvtpk_s(r1[0], r1[1]); w.w = cvtpk_s(r1[2], r1[3]);
            *(u32x4*)mp = w; }
    }
    asm volatile("s_waitcnt lgkmcnt(0)\n\ts_barrier" ::: "memory");
#undef DMA_K
#undef DMA_V
#undef BIAS
#undef START
#undef RESC
#undef ROT
#undef NEARCHK
}
struct G2 { static constexpr int LDS_V = NSLOT * SLOTB, LDS_WS = LDS_V + NSLOT * 2 * SLOTB, LDS_OST = LDS_WS + NW * 64 * 4, LDS_TBL = LDS_OST + NW * 4096, NTBL = GUARD + 1856, LDS_END = LDS_TBL + NTBL * 4; };
static_assert(G2::LDS_END + G2::NTBL * 4 <= 131072, "attention (V128) LDS map (two tables)");
template <int THRL> __device__ __forceinline__ void attn_unit_v128(const UnitDesc& U, lds_ptr shm) {
    int tid_ = threadIdx.x; asm volatile("" : "+v"(tid_));
    const int tid = tid_, lane = tid & 63, r32 = lane & 31, hi = lane >> 5; const int wid = __builtin_amdgcn_readfirstlane(tid >> 6);
    const int q0 = U.q0;
    const bf16h* Qw = U.Q + (long)(q0 + wid * QBLK) * DM;
    const bf16h* Kh = U.K + (long)U.kt0 * KVBLK * DM; const bf16h* Vh = U.V + (long)U.kt0 * KVBLK * DM;
    const unsigned lds0 = (unsigned)(uintptr_t)shm;
    ALDS float* wsf = (ALDS float*)(shm + G2::LDS_WS) + wid * 64;
    const bf16h* ksrc = Kh + (long)lane * DM + wid * 8;
    const bf16h* vsrc = Vh + (long)(16 * (wid & 3) + (lane >> 2)) * DM + (wid >> 2) * 32 + (lane & 3) * 8;
    const unsigned kdst = lds0 + LDS_K + wid * 1024, vdst = lds0 + G2::LDS_V + wid * 1024;
#define DMA_K(t, slot) glds16(ksrc + (long)(t) * KVBLK * DM, (unsigned)__builtin_amdgcn_readfirstlane(kdst + (slot)))
#define DMA_V(t, slot) do { glds16(vsrc + (long)(t) * KVBLK * DM, (unsigned)__builtin_amdgcn_readfirstlane(vdst + 2 * (slot))); glds16(vsrc + (long)(t) * KVBLK * DM + 64, (unsigned)__builtin_amdgcn_readfirstlane(vdst + 2 * (slot) + 8192)); } while (0)
    const lds_cptr Kbase = shm + LDS_K; bf16x8 kf[8];
    const lds_cptr shm3 = (lds_cptr)shm; const lds_cptr kp0 = shm3 + LDS_K + hi * 1024 + r32 * 16; const lds_cptr vp0 = shm3 + G2::LDS_V + ((lane >> 4) & 1) * 32 + (lane & 3) * 8 + (4 * hi + ((lane & 15) >> 2)) * 64;
    const lds_cptr tb0 = shm3 + G2::LDS_TBL + U.tbl_off + 4 * (G2::NTBL - 1 - GUARD - ((q0 - KVBLK * U.kt0) + QBLK * wid + r32 - 4 * hi));
    const int NT = U.NT;
    DMA_K(0, 0); DMA_V(0, 0); DMA_K(1, SLOTB);
    bf16x8 qr[4];
#pragma unroll
    for (int d0 = 0; d0 < 4; ++d0) qr[d0] = *reinterpret_cast<const bf16x8*>(&Qw[(long)r32 * DM + d0 * 16 + hi * 8]);
    float mhat = 0.f, l_reg = 0.f; f32x16 o[4]; o[0] = f32x16{}; o[1] = f32x16{}; o[2] = f32x16{}; o[3] = f32x16{}; asm volatile("" : "+v"(o[0]), "+v"(o[1]), "+v"(o[2]), "+v"(o[3]));
    const int NT_far = U.NT_far; float cb = NT_far > 0 ? U.cfar : 0.f;
    const f32x16 zero16 = f32x16{};
#define BIAS(P0, P1, T0, T1, t) do { const ALDS float* tb_ = (const ALDS float*)(tb0 + 256 * (t)); \
    _Pragma("unroll") for (int r = 0; r < 16; ++r) T0[r] = tb_[(r & 3) + 8 * (r >> 2)]; \
    asm volatile("s_waitcnt lgkmcnt(0)" : "+v"(T0) :: "memory"); \
    _Pragma("unroll") for (int r = 0; r < 16; ++r) P0[r] += T0[r]; \
    _Pragma("unroll") for (int r = 0; r < 16; ++r) T0[r] = tb_[32 + (r & 3) + 8 * (r >> 2)]; \
    asm volatile("s_waitcnt lgkmcnt(0)" : "+v"(T0) :: "memory"); \
    _Pragma("unroll") for (int r = 0; r < 16; ++r) P1[r] += T0[r]; } while (0)
    bool resc = false;
#define START(P0, P1) do { const float rm = rowmax(P0, P1); resc = false; \
    { const float dl = rm < -1e30f ? 0.f : rm + cb; mhat = fadd_s(mhat, dl); const float mr = mhat - cb; \
      _Pragma("unroll") for (int r = 0; r < 16; ++r) { P0[r] = fsub_s(P0[r], mr); P1[r] = fsub_s(P1[r], mr); } } \
    _Pragma("unroll") for (int r = 0; r < 16; ++r) P0[r] = __builtin_amdgcn_exp2f(P0[r]); } while (0)
#define RESC() do { if (resc) { asm volatile("s_waitcnt lgkmcnt(0)" ::: "memory"); \
      _Pragma("unroll") for (int d_ = 0; d_ < 4; ++d_) _Pragma("unroll") for (int r = 0; r < 16; ++r) o[d_][r] *= wsf[crow(r, hi)]; } } while (0)
    f32x16 pA0, pA1, pB0, pB1;
    int sl_prev = 0, sl_cur = 0, sl_next = SLOTB;
#define ROT() do { sl_prev = sl_cur; sl_cur = sl_next; sl_next = (sl_next == (NSLOT - 1) * SLOTB) ? 0 : sl_next + SLOTB; } while (0)
#define NEARCHK(tn) do { if ((tn) == NT_far) cb = 0.f; } while (0)
    DMA_K(2, 2 * SLOTB);
    WAIT_BAR(4);
    { f32x16 z0 = f32x16{}; asm volatile("" : "+v"(z0)); qkt(pA0, pA1, Kbase, qr, z0, r32, hi); } asm volatile("s_nop 15\n\ts_nop 7" : "+v"(pA0), "+v"(pA1)); if (NT_far == 0) BIAS(pA0, pA1, pB0, pB1, 0);
    START(pA0, pA1);
    _Pragma("unroll") for (int r = 0; r < 16; ++r) pA1[r] = __builtin_amdgcn_exp2f(pA1[r]);
    WAIT_BAR(0);
    DMA_K(3, 0); DMA_V(1, SLOTB);
    ROT(); NEARCHK(1);
    kload8(kf, kp0 + sl_cur);
    WAIT_BAR(3);
    s16x4 vlo[8], vhi[8]; u32x4 pw0, pw1, pw2, pw3;
#define PKW(P, B) cvtpk_s(P[B], P[B + 1])
#define PAF(k) __builtin_bit_cast(bf16x8, pw##k)
#define VFR(i) (bf16x8){vlo[i][0], vlo[i][1], vlo[i][2], vlo[i][3], vhi[i][0], vhi[i][1], vhi[i][2], vhi[i][3]}
#define PIN(x) asm volatile("" : "+v"(x))
#define MX3(a, b, c) __builtin_fmaxf(__builtin_fmaxf((a), (b)), (c))
#define GAPA(MF, A0, A1, A2, A3, W0, W1, PW) do { MF; sacc += A0; sacc += A1; sacc += A2; sacc += A3; PIN(sacc); W0; W1; PIN(PW); SBAR(); } while (0)
#define EX(v) __builtin_amdgcn_exp2f(v)
#define GAPB(MF, X, B) do { MF; X[B] = EX(X[B]); X[B + 1] = EX(X[B + 1]); X[B + 2] = EX(X[B + 2]); X[B + 3] = EX(X[B + 3]); PIN(X); SBAR(); } while (0)
#define VRD(i) do { vlo[i] = vtr(vp_ + (((i) >> 2) * 4096 + ((i) & 3) * 1024)); vhi[i] = vtr(vp_ + (((i) >> 2) * 4096 + ((i) & 3) * 1024 + 512)); } while (0)
#define VRD2(i) do { vlo[i] = vtr(vp_ + ((((i) >> 2) + 2) * 4096 + ((i) & 3) * 1024)); vhi[i] = vtr(vp_ + ((((i) >> 2) + 2) * 4096 + ((i) & 3) * 1024 + 512)); } while (0)
#define GAPB2(MF, X, B) do { MF; X[B] = EX(X[B] - mref_); X[B + 1] = EX(X[B + 1] - mref_); PIN(X); SBAR(); } while (0)
#define KRD(G, j) do { if (G) { kload2(kf, kp0 + sl_next, j); SBAR(); } } while (0)
#define STEP(C0, C1, P0, P1, t, GK, GV, GL) do { SBAR(); \
    const lds_cptr vp_ = vp0 + 2 * sl_prev; \
    VRD(0); SBAR(); float sacc = (P0[0] + P0[1]); \
    GAPA(C0 = __builtin_amdgcn_mfma_f32_32x32x16_bf16(kf[0], qr[0], zero16, 0, 0, 0); PIN(kf[0]); PIN(qr[0]), P0[2], P0[3], P0[4], P0[5],     pw0[0] = PKW(P0, 0), pw0[1] = PKW(P0, 2), pw0); \
    VRD(4); SBAR(); GAPA(C1 = __builtin_amdgcn_mfma_f32_32x32x16_bf16(kf[1], qr[0], zero16, 0, 0, 0); PIN(kf[1]); PIN(qr[0]), P0[6], P0[7], P0[8], P0[9],     pw0[2] = PKW(P0, 4), pw0[3] = PKW(P0, 6), pw0); \
    VRD(1); SBAR(); GAPA(C0 = __builtin_amdgcn_mfma_f32_32x32x16_bf16(kf[2], qr[1], C0, 0, 0, 0),   P0[10], P0[11], P0[12], P0[13], pw1[0] = PKW(P0, 8), pw1[1] = PKW(P0, 10), pw1); \
    VRD(5); SBAR(); GAPA(C1 = __builtin_amdgcn_mfma_f32_32x32x16_bf16(kf[3], qr[1], C1, 0, 0, 0),   P0[14], P0[15], P1[0], P1[1],   pw1[2] = PKW(P0, 12), pw1[3] = PKW(P0, 14), pw1); \
    GAPA(C0 = __builtin_amdgcn_mfma_f32_32x32x16_bf16(kf[4], qr[2], C0, 0, 0, 0),   P1[2], P1[3], P1[4], P1[5],     pw2[0] = PKW(P1, 0), pw2[1] = PKW(P1, 2), pw2); \
    GAPA(C1 = __builtin_amdgcn_mfma_f32_32x32x16_bf16(kf[5], qr[2], C1, 0, 0, 0),   P1[6], P1[7], P1[8], P1[9],     pw2[2] = PKW(P1, 4), pw2[3] = PKW(P1, 6), pw2); \
    GAPA(C0 = __builtin_amdgcn_mfma_f32_32x32x16_bf16(kf[6], qr[3], C0, 0, 0, 0),   P1[10], P1[11], P1[12], P1[13], pw3[0] = PKW(P1, 8), pw3[1] = PKW(P1, 10), pw3); \
    GAPA(C1 = __builtin_amdgcn_mfma_f32_32x32x16_bf16(kf[7], qr[3], C1, 0, 0, 0),   P1[14], P1[15], 0.f, 0.f,       pw3[2] = PKW(P1, 12), pw3[3] = PKW(P1, 14), pw3); \
    l_reg += sacc; \
    if (GK) { DMA_K((t) + 3, sl_cur); } if (GV) { DMA_V((t) + 1, sl_next); } \
    if ((t) >= NT_far) BIAS(C0, C1, P0, P1, t); \
    { float a = MX3(C0[0], C0[1], C1[0]), b = MX3(C0[2], C0[3], C1[1]); a = MX3(a, C1[2], C1[3]); \
      _Pragma("unroll") for (int r = 4; r < 16; r += 4) { a = MX3(a, C0[r], C0[r + 1]); b = MX3(b, C0[r + 2], C0[r + 3]); a = MX3(a, C1[r], C1[r + 1]); b = MX3(b, C1[r + 2], C1[r + 3]); } \
      float rm = __builtin_fmaxf(a, b); { auto rr = __builtin_amdgcn_permlane32_swap(__float_as_uint(rm), __float_as_uint(rm), false, false); rm = __builtin_fmaxf(__uint_as_float(rr[0]), __uint_as_float(rr[1])); } \
      rm -= (mhat - cb); resc = false; \
      if (__builtin_expect(__any(rm > (float)THRL), 0)) { const float dl = __builtin_fmaxf(rm, 0.f); mhat += dl; \
        const float f = __builtin_amdgcn_exp2f(-dl); l_reg *= f; if (hi == 0) wsf[r32] = f; resc = true; } } \
    const float mref_ = mhat - cb; \
    SBAR(); \
    VRD(2); VRD(6); SBAR(); \
    GAPB2(o[0] = __builtin_amdgcn_mfma_f32_32x32x16_bf16(PAF(0), VFR(0), o[0], 0, 0, 0), C0, 0); VRD(3); SBAR(); \
    GAPB2(o[1] = __builtin_amdgcn_mfma_f32_32x32x16_bf16(PAF(0), VFR(4), o[1], 0, 0, 0), C0, 2); VRD(7); SBAR(); \
    KRD(GL, 0); GAPB2(o[0] = __builtin_amdgcn_mfma_f32_32x32x16_bf16(PAF(1), VFR(1), o[0], 0, 0, 0), C0, 4); VRD2(0); VRD2(1); SBAR(); \
    KRD(GL, 1); GAPB2(o[1] = __builtin_amdgcn_mfma_f32_32x32x16_bf16(PAF(1), VFR(5), o[1], 0, 0, 0), C0, 6); VRD2(4); VRD2(5); SBAR(); \
    KRD(GL, 2); GAPB2(o[0] = __builtin_amdgcn_mfma_f32_32x32x16_bf16(PAF(2), VFR(2), o[0], 0, 0, 0), C0, 8); VRD2(2); SBAR(); \
    KRD(GL, 3); GAPB2(o[1] = __builtin_amdgcn_mfma_f32_32x32x16_bf16(PAF(2), VFR(6), o[1], 0, 0, 0), C0, 10); VRD2(6); SBAR(); \
    GAPB2(o[0] = __builtin_amdgcn_mfma_f32_32x32x16_bf16(PAF(3), VFR(3), o[0], 0, 0, 0), C0, 12); VRD2(3); SBAR(); \
    GAPB2(o[1] = __builtin_amdgcn_mfma_f32_32x32x16_bf16(PAF(3), VFR(7), o[1], 0, 0, 0), C0, 14); VRD2(7); SBAR(); \
    GAPB2(o[2] = __builtin_amdgcn_mfma_f32_32x32x16_bf16(PAF(0), VFR(0), o[2], 0, 0, 0), C1, 0); \
    GAPB2(o[3] = __builtin_amdgcn_mfma_f32_32x32x16_bf16(PAF(0), VFR(4), o[3], 0, 0, 0), C1, 2); \
    GAPB2(o[2] = __builtin_amdgcn_mfma_f32_32x32x16_bf16(PAF(1), VFR(1), o[2], 0, 0, 0), C1, 4); \
    GAPB2(o[3] = __builtin_amdgcn_mfma_f32_32x32x16_bf16(PAF(1), VFR(5), o[3], 0, 0, 0), C1, 6); \
    GAPB2(o[2] = __builtin_amdgcn_mfma_f32_32x32x16_bf16(PAF(2), VFR(2), o[2], 0, 0, 0), C1, 8); \
    GAPB2(o[3] = __builtin_amdgcn_mfma_f32_32x32x16_bf16(PAF(2), VFR(6), o[3], 0, 0, 0), C1, 10); \
    GAPB2(o[2] = __builtin_amdgcn_mfma_f32_32x32x16_bf16(PAF(3), VFR(3), o[2], 0, 0, 0), C1, 12); \
    GAPB2(o[3] = __builtin_amdgcn_mfma_f32_32x32x16_bf16(PAF(3), VFR(7), o[3], 0, 0, 0), C1, 14); \
    } while (0)
    int t = 1;
    for (; t + 5 < NT; t += 2) {
        STEP(pB0, pB1, pA0, pA1, t, true, true, true);     WAIT_BAR(3); RESC(); ROT(); NEARCHK(t + 1);
        STEP(pA0, pA1, pB0, pB1, t + 1, true, true, true); WAIT_BAR(3); RESC(); ROT(); NEARCHK(t + 2);
    }
#define ENDW(tt) do { if ((tt) + 3 < NT) { WAIT_BAR(3); } else if ((tt) + 2 < NT) { WAIT_BAR(2); } else { WAIT_BAR(0); } } while (0)
    for (; t + 1 < NT; t += 2) {
        STEP(pB0, pB1, pA0, pA1, t, (t + 3 < NT), (t + 1 < NT), (t + 1 < NT));         ENDW(t);     RESC(); ROT(); NEARCHK(t + 1);
        STEP(pA0, pA1, pB0, pB1, t + 1, (t + 4 < NT), (t + 2 < NT), (t + 2 < NT));     ENDW(t + 1); RESC(); ROT(); NEARCHK(t + 2);
    }
    STEP(pB0, pB1, pA0, pA1, NT - 1, false, false, false); RESC();
    { float sacc = pB0[0] + pB0[1]; _Pragma("unroll") for (int r = 2; r < 16; ++r) sacc += pB0[r]; _Pragma("unroll") for (int r = 0; r < 16; ++r) sacc += pB1[r]; l_reg += sacc;
      pw0 = (u32x4){PKW(pB0, 0), PKW(pB0, 2), PKW(pB0, 4), PKW(pB0, 6)}; pw1 = (u32x4){PKW(pB0, 8), PKW(pB0, 10), PKW(pB0, 12), PKW(pB0, 14)}; pw2 = (u32x4){PKW(pB1, 0), PKW(pB1, 2), PKW(pB1, 4), PKW(pB1, 6)}; pw3 = (u32x4){PKW(pB1, 8), PKW(pB1, 10), PKW(pB1, 12), PKW(pB1, 14)};
      int tidD = threadIdx.x; asm volatile("" : "+v"(tidD)); const int laneD = tidD & 63;
      const int vb0 = (int)(lds0 + G2::LDS_V) + ((laneD >> 4) & 1) * 32 + (laneD & 3) * 8 + (4 * (laneD >> 5) + ((laneD & 15) >> 2)) * 64;
      SBAR(); pv(o, vb0 + 2 * sl_cur, PAF(0), PAF(1), PAF(2), PAF(3)); pv(o + 2, vb0 + 2 * sl_cur + 8192, PAF(0), PAF(1), PAF(2), PAF(3)); }
#undef PKW
#undef PAF
#undef VFR
#undef PIN
#undef MX3
#undef GAPA
#undef GAPB
#undef GAPB2
#undef VRD2
#undef EX
#undef VRD
#undef KRD
#undef STEP
#undef ENDW
    int tidE = threadIdx.x; asm volatile("" : "+v"(tidE)); const int laneE = tidE & 63, r32E = laneE & 31, hiE = laneE >> 5;
    { auto rr = __builtin_amdgcn_permlane32_swap(__float_as_uint(l_reg), __float_as_uint(l_reg), false, false); l_reg = __uint_as_float(rr[0]) + __uint_as_float(rr[1]); }
    {
        if (hiE == 0) wsf[32 + r32E] = l_reg; asm volatile("s_waitcnt lgkmcnt(0)" ::: "memory");
        float rli[16];
#pragma unroll
        for (int r = 0; r < 16; ++r) rli[r] = __builtin_amdgcn_rcpf(wsf[32 + crow(r, hiE)]);
        ALDS unsigned short* stg = (ALDS unsigned short*)(shm + G2::LDS_OST) + wid * 2048;
        if (!U.comb) {
            bf16h* Ow = U.O + (long)(q0 + wid * QBLK) * DM;
#pragma unroll
            for (int pss = 0; pss < 2; ++pss) {
#pragma unroll
                for (int r = 0; r < 16; ++r) { const int orow = crow(r, hiE);
#pragma unroll
                    for (int d0 = 0; d0 < 2; ++d0) stg[orow * 64 + d0 * 32 + r32E] = __builtin_bit_cast(unsigned short, (__bf16)(o[2 * pss + d0][r] * rli[r])); }
                asm volatile("s_waitcnt lgkmcnt(0)" ::: "memory");
#pragma unroll
                for (int i = 0; i < 4; ++i) { const int row = i * 8 + (laneE >> 3), ch = laneE & 7; const u32x4 v = *(const ALDS u32x4*)(stg + row * 64 + ch * 8); *(u32x4*)(Ow + (long)row * DM + 64 * pss + ch * 8) = v; }
                asm volatile("s_waitcnt lgkmcnt(0)" ::: "memory");
            }
        } else {
            bf16h* Oc = U.O + (long)(q0 + wid * QBLK) * DM;
            const float LAMBDA_INIT = 0.8f - 0.6f * 0.7408182206817179f;
            float lam; { float d1 = AIN(7)[laneE] * AIN(8)[laneE], d2 = AIN(9)[laneE] * AIN(10)[laneE]; d1 = wave_sum(d1); d2 = wave_sum(d2); lam = __expf(d1) - __expf(d2) + LAMBDA_INIT; }
            const float* subln = AIN(11);
            float dv[2][4][8]; float ssq[4] = {0.f, 0.f, 0.f, 0.f};
#pragma unroll
            for (int pss = 0; pss < 2; ++pss) {
                unsigned long long ga[4][2];
#pragma unroll
                for (int i = 0; i < 4; ++i) { const int row = i * 8 + (laneE >> 3), ch = laneE & 7; const unsigned long long* gp = (const unsigned long long*)(Oc + (long)row * DM + 64 * pss + ch * 8);
                    ga[i][0] = __hip_atomic_load(gp, __ATOMIC_RELAXED, __HIP_MEMORY_SCOPE_AGENT); ga[i][1] = __hip_atomic_load(gp + 1, __ATOMIC_RELAXED, __HIP_MEMORY_SCOPE_AGENT); }
#pragma unroll
                for (int r = 0; r < 16; ++r) { const int orow = crow(r, hiE);
#pragma unroll
                    for (int d0 = 0; d0 < 2; ++d0) stg[orow * 64 + d0 * 32 + r32E] = __builtin_bit_cast(unsigned short, (__bf16)(o[2 * pss + d0][r] * rli[r])); }
                asm volatile("s_waitcnt lgkmcnt(0)" ::: "memory");
#pragma unroll
                for (int i = 0; i < 4; ++i) { const int row = i * 8 + (laneE >> 3), ch = laneE & 7; const u32x4 v1 = *(const ALDS u32x4*)(stg + row * 64 + ch * 8);
                    const unsigned long long g0 = ga[i][0], g1 = ga[i][1];
                    const unsigned a0w = (unsigned)g0, a1w = (unsigned)(g0 >> 32), a2w = (unsigned)g1, a3w = (unsigned)(g1 >> 32);
                    dv[pss][i][0] = bflo(a0w) - lam * bflo(v1.x); dv[pss][i][1] = bfhi(a0w) - lam * bfhi(v1.x); dv[pss][i][2] = bflo(a1w) - lam * bflo(v1.y); dv[pss][i][3] = bfhi(a1w) - lam * bfhi(v1.y);
                    dv[pss][i][4] = bflo(a2w) - lam * bflo(v1.z); dv[pss][i][5] = bfhi(a2w) - lam * bfhi(v1.z); dv[pss][i][6] = bflo(a3w) - lam * bflo(v1.w); dv[pss][i][7] = bfhi(a3w) - lam * bfhi(v1.w);
#pragma unroll
                    for (int e = 0; e < 8; ++e) ssq[i] += dv[pss][i][e] * dv[pss][i][e]; }
                asm volatile("s_waitcnt lgkmcnt(0)" ::: "memory");
            }
#pragma unroll
            for (int i = 0; i < 4; ++i) { float sv = ssq[i]; sv += __shfl_xor(sv, 1); sv += __shfl_xor(sv, 2); sv += __shfl_xor(sv, 4); ssq[i] = (1.0f - LAMBDA_INIT) / sqrtf(sv * (1.0f / 128.0f) + EPS); }
#pragma unroll
            for (int pss = 0; pss < 2; ++pss) { const int ch = laneE & 7;
                const f32x4 ga = *(const f32x4*)(subln + 64 * pss + ch * 8), gb = *(const f32x4*)(subln + 64 * pss + ch * 8 + 4);
#pragma unroll
                for (int i = 0; i < 4; ++i) { const int row = i * 8 + (laneE >> 3); const float rr = ssq[i];
                    u32x4 w; w.x = cvtpk_s(dv[pss][i][0] * rr * ga[0], dv[pss][i][1] * rr * ga[1]); w.y = cvtpk_s(dv[pss][i][2] * rr * ga[2], dv[pss][i][3] * rr * ga[3]);
                    w.z = cvtpk_s(dv[pss][i][4] * rr * gb[0], dv[pss][i][5] * rr * gb[1]); w.w = cvtpk_s(dv[pss][i][6] * rr * gb[2], dv[pss][i][7] * rr * gb[3]);
                    *(u32x4*)(Oc + (long)row * DM + 64 * pss + ch * 8) = w; } }
        }
    }
    asm volatile("s_waitcnt lgkmcnt(0)\n\ts_barrier" ::: "memory");
#undef DMA_K
#undef DMA_V
#undef BIAS
#undef START
#undef RESC
#undef ROT
#undef NEARCHK
}
template <int MODE> __device__ __forceinline__ void build_table(lds_ptr shm, const float* gbt, int col, int dil) {
    ALDS float* tbl = (ALDS float*)(shm + Geo<MODE>::LDS_TBL);
    for (int i = threadIdx.x; i < Geo<MODE>::NTBL; i += NW * 64) { const int dist = i - GUARD; float v = MASKV;
        if (MODE == 0) { if (dist >= 0) v = gbt[col * GBT_N + (dist < GBT_N ? dist : GBT_N - 1)]; }
        else { if (dist >= 0 && dist <= 128) { const int dd = dist * dil; v = gbt[col * GBT_N + (dd < GBT_N ? dd : GBT_N - 1)]; } }
        tbl[i] = v; }
    asm volatile("s_waitcnt vmcnt(0) lgkmcnt(0)\n\ts_barrier" ::: "memory");
}
__device__ __forceinline__ void build_table_v128(lds_ptr shm, const float* gbt, int col, int off) {
    ALDS float* tbl = (ALDS float*)(shm + G2::LDS_TBL + off);
    for (int i = threadIdx.x; i < G2::NTBL; i += NW * 64) { const int dist = i - GUARD; tbl[G2::NTBL - 1 - i] = dist >= 0 ? gbt[col * GBT_N + (dist < GBT_N ? dist : GBT_N - 1)] : MASKV; }
    asm volatile("s_waitcnt vmcnt(0) lgkmcnt(0)\n\ts_barrier" ::: "memory");
}
#undef SBAR
#undef WAIT_BAR
}


typedef GAS unsigned gu32;
constexpr int CW_FIN = 16384;
constexpr int CW_BAR = 4096;
#define XB_TMO      128
#define XB_XCNT(j)  (256  + 64 * (j))
#define XB_XSUB(j)  (1280 + 64 * (j))
#define XB_XGEN(j)  (2304 + 64 * (j))
#define XB_TOP      3328
#define XB_TOPGEN   3392
#define XCD_BAR_WORDS 3456
#define XB_SPIN_CAP (1u << 18)
__device__ __forceinline__ unsigned xb_ld(unsigned* p)              { return __hip_atomic_load(p, __ATOMIC_RELAXED, __HIP_MEMORY_SCOPE_AGENT); }
__device__ __forceinline__ unsigned xb_add(unsigned* p, unsigned v) { return __hip_atomic_fetch_add(p, v, __ATOMIC_RELAXED, __HIP_MEMORY_SCOPE_AGENT); }
__device__ __forceinline__ unsigned xb_xcc_id() { return (unsigned)__builtin_amdgcn_s_getreg((3 << 11) | 20) & 0xFu; }
#define XB_SPIN(cond, bar) do { unsigned _sp = 0; while (cond) { __builtin_amdgcn_s_sleep(1); \
    if ((++_sp & 255u) == 0u) { if (xb_ld(&(bar)[XB_TMO])) break; if (_sp > XB_SPIN_CAP) { atomicAdd(&(bar)[XB_TMO], 1u); break; } } } } while (0)
struct XcdBarrier { unsigned* bar; unsigned x; volatile LAS unsigned* st; };
__device__ __forceinline__ XcdBarrier xcd_barrier_post(unsigned* bar, volatile LAS unsigned* st) {
    XcdBarrier b; b.bar = bar; b.x = xb_xcc_id(); b.st = st;
    if (threadIdx.x == 0) (void)xb_add(&bar[XB_XCNT(b.x)], 1u);
    return b;
}
__device__ __forceinline__ void xcd_barrier_complete(unsigned* bar, unsigned x, unsigned& nloc, unsigned& nx) {
    const unsigned G = gridDim.x * gridDim.y * gridDim.z;
    unsigned sum, cnt, mine, sp = 0u;
    for (;;) {
        sum = 0u; cnt = 0u; mine = 0u;
#pragma unroll
        for (unsigned j = 0; j < 16; ++j) { const unsigned c = xb_ld(&bar[XB_XCNT(j)]); sum += c; cnt += (c > 0u) ? 1u : 0u; mine = (j == x) ? c : mine; }
        if (sum == G) break;
        __builtin_amdgcn_s_sleep(1);
        if ((++sp & 255u) == 0u) { if (xb_ld(&bar[XB_TMO])) break; if (sp > XB_SPIN_CAP) { atomicAdd(&bar[XB_TMO], 1u); break; } }
    }
    nloc = mine > 0u ? mine : 1u; nx = cnt > 0u ? cnt : 1u;
}
__device__ __forceinline__ void xcd_barrier(const XcdBarrier& b) {
    asm volatile("s_waitcnt vmcnt(0)" ::: "memory");
    __syncthreads();
    if (threadIdx.x == 0) {
        unsigned* bar = b.bar;
        __builtin_amdgcn_s_waitcnt(0);
        unsigned nloc = b.st[0], nx = b.st[1];
        if (nloc == 0u) { xcd_barrier_complete(bar, b.x, nloc, nx); b.st[0] = nloc; b.st[1] = nx; }
        const unsigned old = xb_add(&bar[XB_XSUB(b.x)], 1u);
        const unsigned gen = old / nloc;
        if (old + 1u == (gen + 1u) * nloc) {
            __builtin_amdgcn_fence(__ATOMIC_RELEASE, "agent");
            asm volatile("s_waitcnt vmcnt(0)" ::: "memory");
            const unsigned og = xb_add(&bar[XB_TOP], 1u);
            const unsigned tg = og / nx;
            if (og + 1u == (tg + 1u) * nx) xb_add(&bar[XB_TOPGEN], 1u);
            else XB_SPIN(xb_ld(&bar[XB_TOPGEN]) == tg, bar);
            __builtin_amdgcn_fence(__ATOMIC_ACQUIRE, "agent");
            asm volatile("s_waitcnt vmcnt(0)" ::: "memory");
        } else {
            XB_SPIN(xb_ld(&bar[XB_TOPGEN]) == gen, bar);
            __builtin_amdgcn_fence(__ATOMIC_ACQUIRE, "agent");
            asm volatile("s_waitcnt vmcnt(0)" ::: "memory");
        }
    }
    __syncthreads();
}

constexpr int NWAVES = 8;
#ifndef DIFF_V128_V
#define DIFF_V128_V 1
#endif
constexpr bool DIFF_V128 = DIFF_V128_V != 0;
#ifndef DIL_MODE_V
#define DIL_MODE_V 1
#endif
constexpr int DIL_MODE = DIL_MODE_V;
constexpr int RING_BYTES = 131072, LDSCTL_OFF = RING_BYTES, MISC_OFF = LDSCTL_OFF + 320, LDS_BYTES = 147456;
enum Phase { PH_PRO = 0, PH_QKV_A0, PH_ATT_A0, PH_QKV_A1, PH_ATT_A1, PH_QKV_A2, PH_ATT_A2, PH_WO0, PH_UP0, PH_DOWN0, PH_PLE0,
             PH_QKV_B, PH_ATT_B, PH_COMB, PH_WO1, PH_UP1, PH_DOWN1, PH_PLE1, PH_FINAL, N_PHASES };


struct Frame {
    LAS unsigned char* lds; int tid, lane, wave, vcu, G;
};

struct P0Item { const float* W; bf16* WT; const float* gain; int K, N, item, pad; };
__device__ __forceinline__ void p0_item_load(const P0Item& d, f32x4 (&t)[8], f32x4 (&gq)[2], int lane) {
    const int nblk = d.N / 32, kb = d.item / nblk, nb = d.item % nblk, k0 = 64 * kb, n0 = 32 * nb;
#pragma unroll
    for (int i = 0; i < 8; ++i) t[i] = __builtin_nontemporal_load((const f32x4*)(d.W + (size_t)(k0 + (lane >> 3) + 8 * i) * d.N + n0 + 4 * (lane & 7)));
    if (d.gain) { const f32x4* gp = (const f32x4*)(d.gain + k0 + 8 * (lane & 7)); gq[0] = gp[0]; gq[1] = gp[1]; }
    else { gq[0] = (f32x4){1.f, 1.f, 1.f, 1.f}; gq[1] = gq[0]; }
}
__device__ __forceinline__ void p0_item_finish(const P0Item& d, const f32x4 (&t)[8], const f32x4 (&gq)[2], LAS float* scr, int lane) {
    const int nblk = d.N / 32, kb = d.item / nblk, nb = d.item % nblk, k0 = 64 * kb, n0 = 32 * nb;
#pragma unroll
    for (int i = 0; i < 8; ++i) { LAS float* p = scr + ((lane >> 3) + 8 * i) * 33 + 4 * (lane & 7); p[0] = t[i].x; p[1] = t[i].y; p[2] = t[i].z; p[3] = t[i].w; }
    asm volatile("s_waitcnt lgkmcnt(0)" ::: "memory");
    const int c = lane & 7;
#pragma unroll
    for (int j = 0; j < 4; ++j) { const int n = (lane >> 3) + 8 * j; const LAS float* sp = scr + (8 * c) * 33 + n;
        v4u o; o.x = pk2(sp[0 * 33] * gq[0].x, sp[1 * 33] * gq[0].y); o.y = pk2(sp[2 * 33] * gq[0].z, sp[3 * 33] * gq[0].w); o.z = pk2(sp[4 * 33] * gq[1].x, sp[5 * 33] * gq[1].y); o.w = pk2(sp[6 * 33] * gq[1].z, sp[7 * 33] * gq[1].w);
        *(v4u*)(d.WT + (size_t)(n0 + n) * d.K + k0 + 8 * c) = o; }
    asm volatile("s_waitcnt lgkmcnt(0)" ::: "memory");
}

constexpr int I_AQKV = (D / 64) * (NQKV_A / 32), I_DD = (D / 64) * (D / 32), I_BQKV = (D / 64) * (NQKV_B / 32), I_1 = (D / 64) * (FF / 32), I_2 = (FF / 64) * (D / 32), I_P = (PLE / 64) * (D / 32);
constexpr int NITEMS = I_AQKV + 2 * I_DD + I_BQKV + 2 * I_1 + 2 * I_2 + 2 * I_DD + 2 * I_P;
__device__ __forceinline__ P0Item p0_decode(int it) {
    unsigned char* ws = AWS;
    P0Item d; d.pad = 0; d.gain = nullptr; int r = it;
    if (r < I_AQKV) { d.W = AIN(3); d.gain = AIN(12); d.K = D; d.N = NQKV_A; d.WT = (bf16*)(ws + WS_WA_QKV); d.item = r; return d; } r -= I_AQKV;
    if (r < I_DD) { d.W = AIN(4); d.K = D; d.N = D; d.WT = (bf16*)(ws + WS_WA_O); d.item = r; return d; } r -= I_DD;
    if (r < I_BQKV) { d.W = AIN(5); d.gain = AIN(12) + D; d.K = D; d.N = NQKV_B; d.WT = (bf16*)(ws + WS_WB_QKV); d.item = r; return d; } r -= I_BQKV;
    if (r < I_DD) { d.W = AIN(6); d.K = D; d.N = D; d.WT = (bf16*)(ws + WS_WB_O); d.item = r; return d; } r -= I_DD;
    if (r < 2 * I_1) { const int li = r / I_1; d.W = AIN(14) + (size_t)li * D * FF; d.gain = AIN(13) + li * D; d.K = D; d.N = FF; d.WT = (bf16*)(ws + WS_W1 + li * 8 * MiB); d.item = r % I_1; return d; } r -= 2 * I_1;
    if (r < 2 * I_2) { const int li = r / I_2; d.W = AIN(15) + (size_t)li * D * FF; d.K = FF; d.N = D; d.WT = (bf16*)(ws + WS_W2 + li * 8 * MiB); d.item = r % I_2; return d; } r -= 2 * I_2;
    if (r < 2 * I_DD) { const int li = r / I_DD; d.W = AIN(17) + (size_t)li * D * D; d.gain = AIN(16) + li * D; d.K = D; d.N = D; d.WT = (bf16*)(ws + WS_WG + li * 2 * MiB); d.item = r % I_DD; return d; } r -= 2 * I_DD;
    { const int li = r / I_P; d.W = AIN(18) + (size_t)li * PLE * D; d.K = PLE; d.N = D; d.WT = (bf16*)(ws + WS_WP + li * (MiB / 2)); d.item = r % I_P; return d; }
}
constexpr int P_CHUNKS = 2;
__device__ __forceinline__ void p_chunk_load(int c, int gw, int lane, f32x4 (&t)[8]) {
    const f32x4* src = (const f32x4*)AIN(1); const size_t stride = (size_t)256 * NWAVES_C * 64;
#pragma unroll
    for (int j = 0; j < 8; ++j) t[j] = __builtin_nontemporal_load(src + (size_t)(c * 8 + j) * stride + (size_t)gw * 64 + lane);
}
__device__ __forceinline__ void p_chunk_store(int c, int gw, int lane, const f32x4 (&t)[8]) {
    v2u* dst = (v2u*)(AWS + WS_PB); const size_t stride = (size_t)256 * NWAVES_C * 64;
#pragma unroll
    for (int j = 0; j < 8; ++j) { v2u o; o.x = pk2(t[j].x, t[j].y); o.y = pk2(t[j].z, t[j].w); dst[(size_t)(c * 8 + j) * stride + (size_t)gw * 64 + lane] = o; }
}

__device__ __forceinline__ void phase_prologue(const Frame& F, const Args& a) {
    int tl_ = threadIdx.x; asm volatile("" : "+v"(tl_)); const int LANE = tl_ & 63;
    unsigned char* ws = AWS;
    LAS float* scr = (LAS float*)(F.lds + F.wave * 16384);
    const int gw = F.vcu * NWAVES + F.wave, NGW = F.G * NWAVES;
    {
        int it = gw; f32x4 ta[8], tb[8], ga[2], gb[2]; P0Item da = p0_decode(it < NITEMS ? it : 0), db = da;
        if (it < NITEMS) p0_item_load(da, ta, ga, LANE);
#pragma unroll 1
        while (it < NITEMS) {
            const int nx = it + NGW; const bool more = nx < NITEMS;
            if (more) { db = p0_decode(nx); p0_item_load(db, tb, gb, LANE); }
            p0_item_finish(da, ta, ga, scr, LANE);
            da = db; ga[0] = gb[0]; ga[1] = gb[1];
#pragma unroll
            for (int i = 0; i < 8; ++i) ta[i] = tb[i];
            it = nx;
        }
    }
    { f32x4 pt[8];
#pragma unroll 1
      for (int c = 0; c < P_CHUNKS; ++c) { p_chunk_load(c, gw, LANE, pt); p_chunk_store(c, gw, LANE, pt); } }
    {
        float* gbt = (float*)(ws + WS_GBT); const float* rb = AIN(2);
        for (int i = gw * 64 + LANE; i < 16 * GBT_N; i += NGW * 64) { const int c = i / GBT_N, n = i % GBT_N; gbt[i] = rb[rel_bucket(n) * 16 + c] * LOG2E; }
    }
    {
        const float* x = AIN(0); bf16* xa = (bf16*)(ws + WS_XA); float* ssq = (float*)(ws + WS_SSQ);
        for (int m = gw; m < M; m += 2 * NGW) {
            const f32x4* h0 = (const f32x4*)(x + (size_t)m * D) + LANE; const f32x4* h1 = (const f32x4*)(x + (size_t)(m + NGW) * D) + LANE;
            const f32x4 a0 = __builtin_nontemporal_load(h0), a1 = __builtin_nontemporal_load(h0 + 64), a2 = __builtin_nontemporal_load(h0 + 128), a3 = __builtin_nontemporal_load(h0 + 192), b0 = __builtin_nontemporal_load(h1), b1 = __builtin_nontemporal_load(h1 + 64), b2 = __builtin_nontemporal_load(h1 + 128), b3 = __builtin_nontemporal_load(h1 + 192);
            float sa = ((a0.x * a0.x + a0.y * a0.y) + (a0.z * a0.z + a0.w * a0.w)) + ((a1.x * a1.x + a1.y * a1.y) + (a1.z * a1.z + a1.w * a1.w))
                     + ((a2.x * a2.x + a2.y * a2.y) + (a2.z * a2.z + a2.w * a2.w)) + ((a3.x * a3.x + a3.y * a3.y) + (a3.z * a3.z + a3.w * a3.w));
            float sb = ((b0.x * b0.x + b0.y * b0.y) + (b0.z * b0.z + b0.w * b0.w)) + ((b1.x * b1.x + b1.y * b1.y) + (b1.z * b1.z + b1.w * b1.w))
                     + ((b2.x * b2.x + b2.y * b2.y) + (b2.z * b2.z + b2.w * b2.w)) + ((b3.x * b3.x + b3.y * b3.y) + (b3.z * b3.z + b3.w * b3.w));
            v2u* oa = (v2u*)(xa + (size_t)m * D) + LANE; v2u* ob = (v2u*)(xa + (size_t)(m + NGW) * D) + LANE; v2u o;
            o.x = pk2(a0.x, a0.y); o.y = pk2(a0.z, a0.w); oa[0] = o;   o.x = pk2(a1.x, a1.y); o.y = pk2(a1.z, a1.w); oa[64] = o;
            o.x = pk2(a2.x, a2.y); o.y = pk2(a2.z, a2.w); oa[128] = o; o.x = pk2(a3.x, a3.y); o.y = pk2(a3.z, a3.w); oa[192] = o;
            o.x = pk2(b0.x, b0.y); o.y = pk2(b0.z, b0.w); ob[0] = o;   o.x = pk2(b1.x, b1.y); o.y = pk2(b1.z, b1.w); ob[64] = o;
            o.x = pk2(b2.x, b2.y); o.y = pk2(b2.z, b2.w); ob[128] = o; o.x = pk2(b3.x, b3.y); o.y = pk2(b3.z, b3.w); ob[192] = o;
            sa = wave_sum(sa); sb = wave_sum(sb);
            if (LANE == 0) { *(f32x4*)(ssq + (size_t)m * 4) = (f32x4){sa, 0.f, 0.f, 0.f}; *(f32x4*)(ssq + (size_t)(m + NGW) * 4) = (f32x4){sb, 0.f, 0.f, 0.f}; }
        }
    }
}

__device__ __forceinline__ void phase_combine(const Frame& F, const Args& a) {
    int tl_ = threadIdx.x; asm volatile("" : "+v"(tl_)); const int LANE = tl_ & 63;
    unsigned char* ws = AWS;
    const float LAMBDA_INIT = 0.8f - 0.6f * 0.7408182206817179f;
    float d1 = AIN(7)[LANE] * AIN(8)[LANE], d2 = AIN(9)[LANE] * AIN(10)[LANE];
    d1 = wave_sum(d1); d2 = wave_sum(d2);
    const float lam = __expf(d1) - __expf(d2) + LAMBDA_INIT;
    const int gw = F.vcu * NWAVES + F.wave, NGW = F.G * NWAVES;
    bf16* O0 = (bf16*)(ws + WS_MIX); const bf16* O1 = (const bf16*)(ws + WS_XA);
    const float* sub = AIN(11) + (LANE & 7) * 16;
    float sg[16];
#pragma unroll
    for (int i = 0; i < 16; ++i) sg[i] = sub[i] * (1.0f - LAMBDA_INIT);
    for (int m = gw; m < M; m += NGW) {
        v4u* p0 = (v4u*)(O0 + (size_t)m * D + LANE * 16); const v4u* p1 = (const v4u*)(O1 + (size_t)m * D + LANE * 16);
        const v4u a0 = p0[0], a1 = p0[1], b0 = p1[0], b1 = p1[1];
        float v[16];
        v[0] = bflo(a0.x) - lam * bflo(b0.x); v[1] = bfhi(a0.x) - lam * bfhi(b0.x); v[2] = bflo(a0.y) - lam * bflo(b0.y); v[3] = bfhi(a0.y) - lam * bfhi(b0.y);
        v[4] = bflo(a0.z) - lam * bflo(b0.z); v[5] = bfhi(a0.z) - lam * bfhi(b0.z); v[6] = bflo(a0.w) - lam * bflo(b0.w); v[7] = bfhi(a0.w) - lam * bfhi(b0.w);
        v[8] = bflo(a1.x) - lam * bflo(b1.x); v[9] = bfhi(a1.x) - lam * bfhi(b1.x); v[10] = bflo(a1.y) - lam * bflo(b1.y); v[11] = bfhi(a1.y) - lam * bfhi(b1.y);
        v[12] = bflo(a1.z) - lam * bflo(b1.z); v[13] = bfhi(a1.z) - lam * bfhi(b1.z); v[14] = bflo(a1.w) - lam * bflo(b1.w); v[15] = bfhi(a1.w) - lam * bfhi(b1.w);
        float s = 0.f;
#pragma unroll
        for (int i = 0; i < 16; ++i) s += v[i] * v[i];
        s += __shfl_xor(s, 1); s += __shfl_xor(s, 2); s += __shfl_xor(s, 4);
        const float r = 1.0f / sqrtf(s * (1.0f / 128.0f) + EPS);
        v4u o0, o1;
        o0.x = pk2(v[0] * r * sg[0], v[1] * r * sg[1]); o0.y = pk2(v[2] * r * sg[2], v[3] * r * sg[3]); o0.z = pk2(v[4] * r * sg[4], v[5] * r * sg[5]); o0.w = pk2(v[6] * r * sg[6], v[7] * r * sg[7]);
        o1.x = pk2(v[8] * r * sg[8], v[9] * r * sg[9]); o1.y = pk2(v[10] * r * sg[10], v[11] * r * sg[11]); o1.z = pk2(v[12] * r * sg[12], v[13] * r * sg[13]); o1.w = pk2(v[14] * r * sg[14], v[15] * r * sg[15]);
        p0[0] = o0; p0[1] = o1;
    }
}

__device__ __forceinline__ void phase_final(const Frame& F, const Args& a) {
    int tl_ = threadIdx.x; asm volatile("" : "+v"(tl_)); const int LANE = tl_ & 63;
    const int gw = F.vcu * NWAVES + F.wave, NGW = F.G * NWAVES;
    const bf16* hb = (const bf16*)(AWS + WS_XA);
    const f32x4* gr = (const f32x4*)AIN(19) + 2 * LANE;
    const f32x4 g0 = gr[0], g1 = gr[1], g2 = gr[128], g3 = gr[129];
    for (int m = gw; m < M; m += NGW) {
        const v4u* hr = (const v4u*)(hb + (size_t)m * D) + LANE; const v4u w0 = hr[0], w1 = hr[64];
        const f32x4 v0 = {bflo(w0.x), bfhi(w0.x), bflo(w0.y), bfhi(w0.y)}, v1 = {bflo(w0.z), bfhi(w0.z), bflo(w0.w), bfhi(w0.w)};
        const f32x4 v2 = {bflo(w1.x), bfhi(w1.x), bflo(w1.y), bfhi(w1.y)}, v3 = {bflo(w1.z), bfhi(w1.z), bflo(w1.w), bfhi(w1.w)};
        float s = ((v0.x * v0.x + v0.y * v0.y) + (v0.z * v0.z + v0.w * v0.w)) + ((v1.x * v1.x + v1.y * v1.y) + (v1.z * v1.z + v1.w * v1.w))
                + ((v2.x * v2.x + v2.y * v2.y) + (v2.z * v2.z + v2.w * v2.w)) + ((v3.x * v3.x + v3.y * v3.y) + (v3.z * v3.z + v3.w * v3.w));
        const float r = 1.0f / sqrtf(wave_sum(s) * (1.0f / D) + EPS);
        f32x4* o = (f32x4*)(AOUT + (size_t)m * D) + 2 * LANE;
        o[0] = v0 * r * g0; o[1] = v1 * r * g1; o[128] = v2 * r * g2; o[129] = v3 * r * g3;
    }
}


template <int G> __device__ __forceinline__ void phase_attn_dil(const Frame& F) {
    int g = G, dil = 1 << (2 * G); asm volatile("" : "+s"(g), "+s"(dil));
    typedef float f32x16 __attribute__((ext_vector_type(16)));
    unsigned char* ws = AWS;
    int tid_ = threadIdx.x; asm volatile("" : "+v"(tid_));
    const int lane = tid_ & 63, r32 = lane & 31, hi = lane >> 5; const int wid = __builtin_amdgcn_readfirstlane(tid_ >> 6);
    const int h = F.vcu >> 4, mwg = F.vcu & 15;
    LAS float* tbl = (LAS float*)F.lds;
    { const float* gbt = (const float*)(ws + WS_GBT);
      if (tid_ < 192) { const int sd = tid_ - 31; float v = -__builtin_huge_valf();
          if (sd >= 0 && sd <= 128) { const int dd = sd * dil; v = gbt[h * GBT_N + (dd < GBT_N ? dd : GBT_N - 1)]; }
          tbl[191 - tid_] = v; }
      __syncthreads(); }
    const bf16* QK = (const bf16*)(ws + WS_QK); const bf16* KBk = QK + (size_t)M * D; const bf16* VT = (const bf16*)(ws + WS_VT);
    bf16* MIXb = (bf16*)(ws + WS_MIX); float* LSEb = (float*)(ws + WS_LSE);
    const int L = T / dil;
    const LAS float* tb = tbl + (32 - r32 + 4 * hi);
#pragma unroll 1
    for (int it = 0; it < 4; ++it) {
        const int qblk = mwg * 32 + it * 8 + wid; const int pos0 = qblk * 32;
        const int s0 = pos0 % L, seqbase = pos0 - s0; const int b = pos0 / T, rr = (pos0 % T) / L; const int tok0 = b * T + rr;
        bf16x8 qf[4]; bf16x8 kfr[5][4];
        { const bf16* qp = QK + ((((size_t)(pos0 >> 5) * 16 + h) * 8 + hi) * 32 + r32) * 8;
#pragma unroll
          for (int d0 = 0; d0 < 4; ++d0) qf[d0] = *(const bf16x8*)(qp + d0 * 512); }
#pragma unroll
        for (int i = 0; i < 5; ++i) {
            const int kt = s0 - 128 + 32 * i; const int ktc = kt >= 0 ? kt : 0;
            const bf16* kp = KBk + ((((size_t)((seqbase + ktc) >> 5) * 16 + h) * 8 + hi) * 32 + r32) * 8;
#pragma unroll
            for (int d0 = 0; d0 < 4; ++d0) kfr[i][d0] = *(const bf16x8*)(kp + d0 * 512);
        }
        f32x16 S[5];
#pragma unroll
        for (int i = 0; i < 5; ++i) {
            const int kt = s0 - 128 + 32 * i;
            f32x16 acc = {0.f, 0.f, 0.f, 0.f, 0.f, 0.f, 0.f, 0.f, 0.f, 0.f, 0.f, 0.f, 0.f, 0.f, 0.f, 0.f}; asm volatile("" : "+v"(acc));
            if (kt >= 0) {
                acc = __builtin_amdgcn_mfma_f32_32x32x16_bf16(kfr[i][0], qf[0], acc, 0, 0, 0);
                acc = __builtin_amdgcn_mfma_f32_32x32x16_bf16(kfr[i][1], qf[1], acc, 0, 0, 0);
                acc = __builtin_amdgcn_mfma_f32_32x32x16_bf16(kfr[i][2], qf[2], acc, 0, 0, 0);
                acc = __builtin_amdgcn_mfma_f32_32x32x16_bf16(kfr[i][3], qf[3], acc, 0, 0, 0);
            }
            S[i] = acc;
        }
        __builtin_amdgcn_sched_barrier(0);
        {
          f32x16 tv[5];
#pragma unroll
          for (int i = 0; i < 5; ++i)
#pragma unroll
            for (int r = 0; r < 16; ++r) tv[i][r] = tb[32 * i + ((r & 3) + 8 * (r >> 2))];
          asm volatile("s_waitcnt lgkmcnt(0)" : "+v"(tv[0]), "+v"(tv[1]), "+v"(tv[2]), "+v"(tv[3]), "+v"(tv[4]));
#pragma unroll
          for (int i = 0; i < 5; ++i) {
            const int kt = s0 - 128 + 32 * i;
#pragma unroll
            for (int r = 0; r < 16; ++r) S[i][r] = kt >= 0 ? S[i][r] + tv[i][r] : -__builtin_huge_valf();
          }
        }
        __builtin_amdgcn_sched_barrier(0);
        v4u vfr[5][2][2];
#pragma unroll
        for (int i = 0; i < 5; ++i) {
            const int kt = s0 - 128 + 32 * i; const int ktc = kt >= 0 ? kt : 0;
            const bf16* vp = VT + ((((size_t)((seqbase + ktc) >> 5) * 16 + h) * 8 + hi) * 32 + r32) * 8;
#pragma unroll
            for (int ks = 0; ks < 2; ++ks) { vfr[i][ks][0] = *(const v4u*)(vp + (ks * 4 + 0) * 256); vfr[i][ks][1] = *(const v4u*)(vp + (ks * 4 + 2) * 256); }
        }
        float mx = -__builtin_huge_valf();
#pragma unroll
        for (int i = 0; i < 5; ++i)
#pragma unroll
            for (int r = 0; r < 16; ++r) mx = fmaxf(mx, S[i][r]);
        mx = fmaxf(mx, __shfl_xor(mx, 32));
        float lsum = 0.f;
#pragma unroll
        for (int i = 0; i < 5; ++i)
#pragma unroll
            for (int r = 0; r < 16; ++r) { const float p = __builtin_amdgcn_exp2f(S[i][r] - mx); S[i][r] = p; lsum += p; }
        lsum += __shfl_xor(lsum, 32);
        f32x16 o0 = {0.f, 0.f, 0.f, 0.f, 0.f, 0.f, 0.f, 0.f, 0.f, 0.f, 0.f, 0.f, 0.f, 0.f, 0.f, 0.f}, o1 = o0; asm volatile("" : "+v"(o0), "+v"(o1));
        const int tokq = tok0 + (s0 + r32) * dil;
        float la_pre = 0.f; if (g > 0) la_pre = LSEb[(size_t)tokq * 16 + h];
#pragma unroll
        for (int i = 0; i < 5; ++i) {
            const int kt = s0 - 128 + 32 * i;
            if (kt >= 0) {
#pragma unroll
                for (int ks = 0; ks < 2; ++ks) {
                    v4u pa; pa.x = pg8::cvt_pk_bf16(S[i][8 * ks + 0], S[i][8 * ks + 1]); pa.y = pg8::cvt_pk_bf16(S[i][8 * ks + 2], S[i][8 * ks + 3]);
                    pa.z = pg8::cvt_pk_bf16(S[i][8 * ks + 4], S[i][8 * ks + 5]); pa.w = pg8::cvt_pk_bf16(S[i][8 * ks + 6], S[i][8 * ks + 7]);
                    o0 = __builtin_amdgcn_mfma_f32_32x32x16_bf16(__builtin_bit_cast(bf16x8, pa), __builtin_bit_cast(bf16x8, vfr[i][ks][0]), o0, 0, 0, 0);
                    o1 = __builtin_amdgcn_mfma_f32_32x32x16_bf16(__builtin_bit_cast(bf16x8, pa), __builtin_bit_cast(bf16x8, vfr[i][ks][1]), o1, 0, 0, 0);
                }
            }
        }
        float lse_g = mx + __builtin_amdgcn_logf(lsum);
        float ca = 0.f, cg = __builtin_amdgcn_rcpf(lsum), lse_new = lse_g;
        if (g > 0) { const float la = la_pre; const float Mx = fmaxf(la, lse_g); const float wa = __builtin_amdgcn_exp2f(la - Mx), wg = __builtin_amdgcn_exp2f(lse_g - Mx);
            const float inv = __builtin_amdgcn_rcpf(wa + wg); ca = wa * inv; cg = wg * inv * cg; lse_new = Mx + __builtin_amdgcn_logf(wa + wg); }
        if (hi == 0) LSEb[(size_t)tokq * 16 + h] = lse_new;
        asm volatile("s_nop 15\n\ts_nop 15\n\ts_nop 15\n\ts_nop 15" : "+v"(o0), "+v"(o1));
        unsigned short mv0[16], mv1[16];
        if (g > 0) {
#pragma unroll
            for (int r = 0; r < 16; ++r) { const int qrow = (r & 3) + 8 * (r >> 2) + 4 * hi; const bf16* mp = MIXb + (size_t)(tok0 + (s0 + qrow) * dil) * D + h * 64 + r32; mv0[r] = mp[0]; mv1[r] = mp[32]; }
        } else {
#pragma unroll
            for (int r = 0; r < 16; ++r) { mv0[r] = 0; mv1[r] = 0; }
        }
        asm volatile("" ::: "memory");
#pragma unroll
        for (int r = 0; r < 16; ++r) {
            const int qrow = (r & 3) + 8 * (r >> 2) + 4 * hi;
            const float cgr = __shfl(cg, qrow), car = __shfl(ca, qrow);
            bf16* mp = MIXb + (size_t)(tok0 + (s0 + qrow) * dil) * D + h * 64 + r32;
            const float v0 = o0[r] * cgr + car * bf2f(mv0[r]), v1 = o1[r] * cgr + car * bf2f(mv1[r]);
            mp[0] = (bf16)f2bf(v0); mp[32] = (bf16)f2bf(v1);
        }
    }
}
__device__ __forceinline__ void phase_attn_dil_valu(const Frame& F, int g, int dil) {
    unsigned char* ws = AWS;
    int tid_ = threadIdx.x; asm volatile("" : "+v"(tid_));
    const int lane = tid_ & 63; const int wid = __builtin_amdgcn_readfirstlane(tid_ >> 6);
    LAS float* sp = (LAS float*)F.lds + wid * 192;
    const bf16* QK = (const bf16*)(ws + WS_QK); const bf16* VT = (const bf16*)(ws + WS_VT); const float* gbt = (const float*)(ws + WS_GBT);
    bf16* MIX = (bf16*)(ws + WS_MIX); float* LSE = (float*)(ws + WS_LSE);
    const int L = T / dil;
#pragma unroll 1
    for (int wt = F.vcu * NWAVES + wid; wt < M * 16; wt += pg8::GRID * NWAVES) {
        const int h = wt & 15, pos = wt >> 4; const int s = pos % L; const int token = perm_to_token(pos, dil);
        const bf16* q = QK + (size_t)pos * 2048 + h * 64;
        float lg0 = -3e38f, lg1 = -3e38f, lg2 = -3e38f;
#pragma unroll
        for (int c = 0; c < 3; ++c) {
            const int sd = c * 64 + lane; float v = -3e38f;
            if (sd <= 128 && s - sd >= 0) {
                const bf16* k = QK + (size_t)(pos - sd) * 2048 + 1024 + h * 64; float acc = 0.f;
#pragma unroll
                for (int e = 0; e < 64; e += 8) { const v4u qa = *(const v4u*)(q + e), ka = *(const v4u*)(k + e);
                    acc += bflo(qa.x) * bflo(ka.x) + bfhi(qa.x) * bfhi(ka.x) + bflo(qa.y) * bflo(ka.y) + bfhi(qa.y) * bfhi(ka.y)
                         + bflo(qa.z) * bflo(ka.z) + bfhi(qa.z) * bfhi(ka.z) + bflo(qa.w) * bflo(ka.w) + bfhi(qa.w) * bfhi(ka.w); }
                { const int dd = sd * dil; v = acc + gbt[h * GBT_N + (dd < GBT_N ? dd : GBT_N - 1)]; }
            }
            if (c == 0) lg0 = v; else if (c == 1) lg1 = v; else lg2 = v;
        }
        const float mx = wave_max(fmaxf(fmaxf(lg0, lg1), lg2));
        const float p0 = lg0 > -1e38f ? exp2f(lg0 - mx) : 0.f, p1 = lg1 > -1e38f ? exp2f(lg1 - mx) : 0.f, p2 = lg2 > -1e38f ? exp2f(lg2 - mx) : 0.f;
        const float sum = wave_sum(p0 + p1 + p2);
        sp[lane] = p0; sp[64 + lane] = p1; sp[128 + lane] = p2;
        asm volatile("s_waitcnt lgkmcnt(0)" ::: "memory");
        const bf16* vt = VT + (size_t)(h * 64 + lane) * M + pos; const int nk = s < 128 ? s : 128;
        float o = 0.f;
        for (int sd = 0; sd <= nk; ++sd) o += sp[sd] * bf2f(vt[-sd]);
        asm volatile("s_waitcnt lgkmcnt(0)" ::: "memory");
        o /= sum; float lse2 = mx + log2f(sum);
        float* lsep = LSE + (size_t)token * 16 + h; bf16* mp = MIX + (size_t)token * D + h * 64 + lane;
        if (g > 0) { const float la = *lsep; const float Mx = fmaxf(la, lse2); const float wa = exp2f(la - Mx), wg = exp2f(lse2 - Mx);
            o = (wa * bf2f(*mp) + wg * o) / (wa + wg); lse2 = Mx + log2f(wa + wg); }
        *mp = (bf16)f2bf(o);
        if (lane == 0) *lsep = lse2;
    }
}
__device__ __forceinline__ void phase_attn_dil_pipe(const Frame& F, int g, int dil) {
    unsigned char* ws = AWS; att::lds_ptr shm = (att::lds_ptr)F.lds;
    const int h = F.vcu >> 4;
    att::build_table<1>(shm, (const float*)(ws + WS_GBT), h, dil);
    const int L = T / dil;
#pragma unroll 1
    for (int i = 0; i < 4; ++i) {
        const int blk = (F.vcu * 4 + i) & 63; const int pos0 = blk * 256; const int s0 = pos0 % L, seqbase = pos0 - s0;
        const int b = pos0 / T, r = (pos0 % T) / L;
        att::UnitDesc U;
        U.Q = (const att::bf16h*)(ws + WS_QB) + (size_t)seqbase * D + h * 64; U.K = (const att::bf16h*)(ws + WS_KB) + (size_t)seqbase * D + h * 64; U.V = (const att::bf16h*)(ws + WS_VB) + (size_t)seqbase * D + h * 64;
        U.q0 = s0; U.kt0 = s0 == 0 ? 0 : s0 / 64 - 2; U.NT = s0 == 0 ? 4 : 6; U.NT_far = 0; U.cfar = 0.f; U.tbl_off = 0; U.comb = 0;
        U.O = nullptr; U.MIXp = (att::bf16h*)(ws + WS_MIX) + h * 64; U.LSEp = (float*)(ws + WS_LSE) + h; U.tok0 = b * T + r; U.dil = dil; U.g = g;
        att::attn_unit<1, 8>(U, shm);
    }
}
__device__ __forceinline__ void phase_attn_dil_lds(const Frame& F, int g, int dil) {
    typedef __bf16 v2bf __attribute__((ext_vector_type(2)));
    unsigned char* ws = AWS;
    int tid_ = threadIdx.x; asm volatile("" : "+v"(tid_));
    const int lane = tid_ & 63, ql = lane & 31, hf = lane >> 5; const int wid = __builtin_amdgcn_readfirstlane(tid_ >> 6);
    const int h = F.vcu >> 4;
    constexpr int PITCH = 132, KL = 0, VL = 384 * PITCH, TB = 2 * 384 * PITCH;
    LAS unsigned char* lds = F.lds;
    if (tid_ < 129) { const int dd = tid_ * dil; ((LAS float*)(lds + TB))[tid_] = ((const float*)(ws + WS_GBT))[h * GBT_N + (dd < GBT_N ? dd : GBT_N - 1)]; }
    const int L = T / dil;
    const bf16* Qb = (const bf16*)(ws + WS_QB); const bf16* Kb = (const bf16*)(ws + WS_KB); const bf16* Vb = (const bf16*)(ws + WS_VB);
#pragma unroll 1
    for (int it = 0; it < 4; ++it) {
        const int blk = (F.vcu * 4 + it) & 63; const int pos0 = blk * 256; const int s0 = pos0 % L, seqbase = pos0 - s0;
        const int b = pos0 / T, rr = (pos0 % T) / L; const int tok0 = b * T + rr;
        const bf16* Kg = Kb + (size_t)seqbase * D + h * 64; const bf16* Vg = Vb + (size_t)seqbase * D + h * 64; const bf16* Qg = Qb + (size_t)seqbase * D + h * 64;
        __syncthreads();
#pragma unroll 2
        for (int c = tid_; c < 384 * 8; c += NWAVES * 64) {
            const int row = c >> 3, part = c & 7, srow = s0 - 128 + row;
            v4u kv = {0u, 0u, 0u, 0u}, vv = kv;
            if (srow >= 0) { kv = *(const v4u*)(Kg + (size_t)srow * D + part * 8); vv = *(const v4u*)(Vg + (size_t)srow * D + part * 8); }
            LAS unsigned* kd = (LAS unsigned*)(lds + KL + row * PITCH + part * 16); LAS unsigned* vd = (LAS unsigned*)(lds + VL + row * PITCH + part * 16);
            kd[0] = kv.x; kd[1] = kv.y; kd[2] = kv.z; kd[3] = kv.w; vd[0] = vv.x; vd[1] = vv.y; vd[2] = vv.z; vd[3] = vv.w;
        }
        __syncthreads();
        const int rho = wid * 32 + ql, sq = s0 + rho;
        unsigned qd[16];
        { const bf16* qp = Qg + (size_t)sq * D + hf * 32;
#pragma unroll
          for (int j = 0; j < 4; ++j) { const v4u t = *(const v4u*)(qp + 8 * j); qd[4 * j] = t.x; qd[4 * j + 1] = t.y; qd[4 * j + 2] = t.z; qd[4 * j + 3] = t.w; } }
        float o[32];
#pragma unroll
        for (int e = 0; e < 32; ++e) o[e] = 0.f;
        float l = 0.f, mref = 0.f;
        const LAS unsigned char* kbase = lds + KL + (rho + 128) * PITCH + hf * 64; const LAS unsigned char* vbase = lds + VL + (rho + 128) * PITCH + hf * 64;
        const LAS float* tbl = (const LAS float*)(lds + TB);
#pragma unroll 1
        for (int sd = 0; sd <= 128; ++sd) {
            const LAS unsigned* kp = (const LAS unsigned*)(kbase - sd * PITCH);
            float part = 0.f;
#pragma unroll
            for (int j = 0; j < 16; ++j) part = __builtin_amdgcn_fdot2_f32_bf16(__builtin_bit_cast(v2bf, qd[j]), __builtin_bit_cast(v2bf, kp[j]), part, false);
            const auto sw = __builtin_amdgcn_permlane32_swap(__float_as_uint(part), __float_as_uint(part), false, false);
            float logit = __uint_as_float(sw[0]) + __uint_as_float(sw[1]) + tbl[sd];
            if (sq - sd < 0) logit = -__builtin_huge_valf();
            if (sd == 0) mref = logit;
            float d = logit - mref;
            if (__any(d > 16.0f)) { const float dl = d > 0.f ? d : 0.f; mref += dl; d -= dl; const float f = __builtin_amdgcn_exp2f(-dl); l *= f;
#pragma unroll
                for (int e = 0; e < 32; ++e) o[e] *= f; }
            const float p = __builtin_amdgcn_exp2f(d);
            l += p;
            const LAS unsigned* vp = (const LAS unsigned*)(vbase - sd * PITCH);
#pragma unroll
            for (int j = 0; j < 16; ++j) { const unsigned w = vp[j]; o[2 * j] += p * bflo(w); o[2 * j + 1] += p * bfhi(w); }
        }
        const size_t tok = (size_t)tok0 + (size_t)sq * dil;
        float lse_g = mref + __builtin_amdgcn_logf(l);
        float ca = 0.f, cg = 1.0f / l, lse_new = lse_g;
        float* lsep = (float*)(ws + WS_LSE) + tok * 16 + h;
        if (g > 0) { const float la = *lsep; const float Mx = fmaxf(la, lse_g); const float wa = __builtin_amdgcn_exp2f(la - Mx), wg = __builtin_amdgcn_exp2f(lse_g - Mx);
            const float inv = 1.0f / (wa + wg); ca = wa * inv; cg = wg * inv * cg; lse_new = Mx + __builtin_amdgcn_logf(wa + wg); }
        bf16* mp = (bf16*)(ws + WS_MIX) + tok * D + h * 64 + hf * 32;
#pragma unroll
        for (int j = 0; j < 4; ++j) {
            float v[8];
#pragma unroll
            for (int e = 0; e < 8; ++e) v[e] = o[8 * j + e] * cg;
            if (g > 0) { const v4u pv_ = *(const v4u*)(mp + 8 * j);
                v[0] += ca * bflo(pv_.x); v[1] += ca * bfhi(pv_.x); v[2] += ca * bflo(pv_.y); v[3] += ca * bfhi(pv_.y);
                v[4] += ca * bflo(pv_.z); v[5] += ca * bfhi(pv_.z); v[6] += ca * bflo(pv_.w); v[7] += ca * bfhi(pv_.w); }
            v4u w; w.x = pk2(v[0], v[1]); w.y = pk2(v[2], v[3]); w.z = pk2(v[4], v[5]); w.w = pk2(v[6], v[7]);
            *(v4u*)(mp + 8 * j) = w;
        }
        if (hf == 0) *lsep = lse_new;
    }
    __syncthreads();
}
__device__ __forceinline__ void phase_attn_diff(const Frame& F, const Args& a) {
    unsigned char* ws = AWS; att::lds_ptr shm = (att::lds_ptr)F.lds;
    const int G8 = F.vcu >> 3, sidx = F.vcu & 7;
    { const int VH = 2 * G8; const int h = (VH >> 2) & 7, j = (VH >> 1) & 1; att::build_table<0>(shm, (const float*)(ws + WS_GBT), h * 2 + j, 1); }
#pragma unroll 1
    for (int it = 0; it < 8; ++it) {
        const int VH = 2 * G8 + (it >> 2); const int b = VH >> 5, h = (VH >> 2) & 7, j = (VH >> 1) & 1, c = VH & 1;
        const int i = it & 3; const int qb = i == 0 ? sidx : i == 1 ? 15 - sidx : i == 2 ? 16 + sidx : 31 - sidx;
        att::UnitDesc U;
        const size_t rb = (size_t)b * T * D;
        U.Q = (const att::bf16h*)(ws + WS_QB) + rb + h * 128 + j * 64; U.K = (const att::bf16h*)(ws + WS_KB) + rb + h * 128 + j * 64; U.V = (const att::bf16h*)(ws + WS_VB) + rb + h * 128 + c * 64;
        U.q0 = qb * 256; U.kt0 = 0; U.NT = 4 * qb + 4;
        U.NT_far = U.q0 >= 1576 ? (U.q0 - 1576) / 64 + 1 : 0; U.cfar = ((const float*)(ws + WS_GBT))[(h * 2 + j) * GBT_N + GBT_N - 1];
        U.tbl_off = 0; U.comb = 0;
        U.O = (att::bf16h*)(ws + (j == 0 ? WS_MIX : WS_XA)) + rb + h * 128 + c * 64;
        U.MIXp = nullptr; U.LSEp = nullptr; U.tok0 = 0; U.dil = 1; U.g = 0;
        att::attn_unit<0, 8>(U, shm);
    }
}

__device__ __forceinline__ void phase_attn_diff_v128(const Frame& F) {
    unsigned char* ws = AWS; att::lds_ptr shm = (att::lds_ptr)F.lds;
    const int BH = F.vcu >> 4, sidx = F.vcu & 15; const int b = BH >> 3, h = BH & 7;
    const float* gbt = (const float*)(ws + WS_GBT);
    att::build_table_v128(shm, gbt, h * 2 + 0, 0); att::build_table_v128(shm, gbt, h * 2 + 1, att::G2::NTBL * 4);
#pragma unroll 1
    for (int i = 0; i < 4; ++i) {
        const int j = i & 1; const int qb = (i >> 1) == 0 ? sidx : 31 - sidx;
        att::UnitDesc U;
        const size_t rb = (size_t)b * T * D;
        U.Q = (const att::bf16h*)(ws + WS_QB) + rb + h * 128 + j * 64; U.K = (const att::bf16h*)(ws + WS_KB) + rb + h * 128 + j * 64; U.V = (const att::bf16h*)(ws + WS_VB) + rb + h * 128;
        U.q0 = qb * 256; U.kt0 = 0; U.NT = 4 * qb + 4;
        U.NT_far = U.q0 >= 1576 ? (U.q0 - 1576) / 64 + 1 : 0; U.cfar = gbt[(h * 2 + j) * GBT_N + GBT_N - 1]; U.tbl_off = j * att::G2::NTBL * 4;
        U.O = (att::bf16h*)(ws + WS_MIX) + rb + h * 128; U.comb = j;
        U.MIXp = nullptr; U.LSEp = nullptr; U.tok0 = 0; U.dil = 1; U.g = 0;
        att::attn_unit_v128<8>(U, shm);
    }
}

__global__ void __launch_bounds__(NWAVES * 64, 2) mk_fwd(Args args) {
    extern __shared__ __attribute__((aligned(16))) unsigned char lds[];
    Frame F;
    F.lds = (LAS unsigned char*)lds;
    F.tid = 0; F.lane = 0; F.wave = __builtin_amdgcn_readfirstlane((int)threadIdx.x >> 6);
    F.G = gridDim.x; { const int bx = blockIdx.x; F.vcu = (F.G % 8 == 0) ? (bx % 8) * (F.G / 8) + bx / 8 : bx; }
    if (F.G != pg8::GRID) return;
    const int lo = args.ph_lo, hi = args.ph_hi;
#define IN(k) (lo <= (k) && (k) < hi)
    for (int u = threadIdx.x; u < (LDS_BYTES - LDSCTL_OFF) / 4; u += NWAVES * 64) ((LAS unsigned*)(F.lds + LDSCTL_OFF))[u] = 0u;
    __syncthreads();
    XcdBarrier bar; bar.bar = nullptr; bar.x = 0; bar.st = nullptr;
    if (hi - lo > 1) bar = xcd_barrier_post((unsigned*)(AWS + WS_CTL) + CW_BAR, (volatile LAS unsigned*)(F.lds + MISC_OFF) + 8);
#define SEAM(k) do { if (IN(k) && IN((k) + 1)) xcd_barrier(bar); } while (0)
    unsigned char* ws = AWS;
    const bf16* XA = (const bf16*)(ws + WS_XA);
#define HB_A ((bf16*)(ws + WS_XA))
#define HB_B ((bf16*)AOUT)
#define ssqp(i) ((float*)(ws + WS_SSQ + (size_t)(i) * SSQ_STRIDE))
    if (IN(PH_PRO)) phase_prologue(F, args);
    SEAM(PH_PRO);
#define QKV_A_GEMM_ROWMAJOR(g, DIL) { \
        pg8::Gemm gm{XA, (const bf16*)(ws + WS_WA_QKV) + (size_t)(g) * 3072 * D}; \
        pg8::EpiRowScale E{(bf16*)(ws + WS_QB), D, ssqp(0), DIL, 1, (size_t)M * D, C2, 0, 0}; \
        pg8::gemm_phase<pg8::EpiRowScale, true, M, NQKV_B, D, D, D, DIL, 1>(F.lds, gm, E); }
#define QKV_A_GEMM(g, DIL) { \
        { pg8::Gemm gm{XA, (const bf16*)(ws + WS_WA_QKV) + (size_t)(g) * 3072 * D}; \
          pg8::EpiRowScale E{(bf16*)(ws + WS_QK), D, ssqp(0), DIL, 1, (size_t)M * D, C2, 0, 1};     \
          pg8::gemm_phase<pg8::EpiRowScale, true, M, 2048, D, D, D, DIL, 1>(F.lds, gm, E); } \
        { pg8::Gemm gm{(const bf16*)(ws + WS_WA_QKV) + ((size_t)(g) * 3072 + 2048) * D, XA}; \
          pg8::EpiVT E{(bf16*)(ws + WS_VT), M, ssqp(0), DIL}; \
          pg8::gemm_phase<pg8::EpiVT, true, D, M, D, D, D, 1, DIL>(F.lds, gm, E); } }
#pragma unroll 1
    for (int g = 0; g < 3; ++g) {
        if (IN(PH_QKV_A0 + 2 * g)) { if (g == 0) QKV_A_GEMM(0, 1) else if (g == 1) QKV_A_GEMM(1, 4) else QKV_A_GEMM(2, 16) }
        SEAM(PH_QKV_A0 + 2 * g);
        if (IN(PH_ATT_A0 + 2 * g)) { if (g == 0) phase_attn_dil<0>(F); else if (g == 1) phase_attn_dil<1>(F); else phase_attn_dil<2>(F); }
        SEAM(PH_ATT_A0 + 2 * g);
    }
#define LAYER_TAIL(li, pb) \
    if (IN(pb)) {         \
        pg8::Gemm gm{(const bf16*)(ws + WS_MIX), (const bf16*)(ws + ((li) == 0 ? WS_WA_O : WS_WB_O))}; \
        pg8::EpiRes<false, false> E{(li) == 0 ? HB_A : HB_B, HB_A, ssqp(1 + 3 * (li)), nullptr, nullptr, nullptr, nullptr, nullptr};     \
        pg8::gemm_phase<pg8::EpiRes<false, false>, false, M, D, D, D, D, 1, 1>(F.lds, gm, E); \
    } \
    SEAM(pb); \
    if (IN((pb) + 1)) {     \
        pg8::Gemm gm{HB_A, (const bf16*)(ws + WS_W1 + (li) * 8 * MiB)}; \
        pg8::EpiRowScale E{(bf16*)(ws + WS_H), FF, ssqp(1 + 3 * (li)), 1, 0, 0, 1.0f, 1, 0}; \
        pg8::gemm_phase<pg8::EpiRowScale, true, M, FF, D, D, D, 1, 1>(F.lds, gm, E); \
    } \
    SEAM((pb) + 1); \
    if (IN((pb) + 2)) {     \
        pg8::Gemm gm{(const bf16*)(ws + WS_H), (const bf16*)(ws + WS_W2 + (li) * 8 * MiB)}; \
        pg8::EpiRes<false, false> E{HB_A, HB_A, ssqp(2 + 3 * (li)), nullptr, nullptr, nullptr, nullptr, nullptr}; \
        pg8::gemm_phase<pg8::EpiRes<false, false>, false, M, D, FF, FF, FF, 1, 1>(F.lds, gm, E); \
    } \
    SEAM((pb) + 2); \
    if (IN((pb) + 3)) {     \
        { pg8::Gemm gm{(const bf16*)(ws + WS_PB) + (size_t)(li) * M * PLE, (const bf16*)(ws + WS_WP + (li) * (MiB / 2))}; \
          pg8::EpiRowScale E{(bf16*)(ws + WS_PROJ), D, nullptr, 1, 0, 0, 1.0f, 0, 0}; \
          pg8::gemm_phase<pg8::EpiRowScale, true, M, D, PLE, PLE, PLE, 1, 1>(F.lds, gm, E); } \
        { pg8::Gemm gm{HB_A, (const bf16*)(ws + WS_WG + (li) * 2 * MiB)}; \
          pg8::EpiRes<false, (li) == 1> E{HB_A, HB_B  , ssqp((li) == 0 ? 3 : 6), ssqp(2 + 3 * (li)), (const bf16*)(ws + WS_PROJ), AOUT, AIN(19), (unsigned*)(ws + WS_CTL) + CW_FIN}; \
          pg8::gemm_phase<pg8::EpiRes<false, (li) == 1>, false, M, D, D, D, D, 1, 1>(F.lds, gm, E); } \
    } \
    SEAM((pb) + 3);
    LAYER_TAIL(0, PH_WO0)
    if (IN(PH_QKV_B)) {
        pg8::Gemm gm{HB_B, (const bf16*)(ws + WS_WB_QKV)};
        pg8::EpiRowScale E{(bf16*)(ws + WS_QB), D, ssqp(3), 1, 1, (size_t)M * D, C2, 0, 0};
        pg8::gemm_phase<pg8::EpiRowScale, true, M, NQKV_B, D, D, D, 1, 1>(F.lds, gm, E);
    }
    SEAM(PH_QKV_B);
    if (IN(PH_ATT_B)) { if (DIFF_V128) phase_attn_diff_v128(F); else phase_attn_diff(F, args); }
    SEAM(PH_ATT_B);
    if (!DIFF_V128) { if (IN(PH_COMB)) phase_combine(F, args); SEAM(PH_COMB); }
    LAYER_TAIL(1, PH_WO1)
#undef IN
}


#ifndef ONE_LAUNCH_V
#define ONE_LAUNCH_V 1
#endif
constexpr bool ONE_LAUNCH = ONE_LAUNCH_V != 0;
static void launch_mk(Args a, int lo, int hi, hipStream_t stream) {
    a.ph_lo = lo; a.ph_hi = hi;
    hipLaunchKernelGGL(mk_fwd, dim3(256), dim3(NWAVES * 64), LDS_BYTES, stream, a);
}
extern "C" void kernel_launch(void* const* d_in, const int* in_sizes, int n_in, void* d_out, int out_size, void* d_ws, size_t ws_size, hipStream_t stream) {
    static int ok = 0;
    if (ok == 0) {
        if (n_in != 20 || in_sizes[0] != M * D || out_size != M * D || ws_size < WS_END) { fprintf(stderr, "kernel_launch: unexpected shapes (n_in %d, in0 %d, out %d, ws %zu)\n", n_in, n_in > 0 ? in_sizes[0] : -1, out_size, ws_size); ok = -1; return; }
        if (hipFuncSetAttribute((const void*)mk_fwd, hipFuncAttributeMaxDynamicSharedMemorySize, LDS_BYTES) != hipSuccess) { fprintf(stderr, "kernel_launch: hipFuncSetAttribute failed\n"); ok = -1; return; }
        ok = 1;
    }
    if (ok < 0) return;
    unsigned char* ws = (unsigned char*)d_ws;
    (void)hipMemsetAsync(ws + WS_CTL, 0, CTL_ZERO_BYTES, stream);
    Args a{};
    for (int i = 0; i < 20; ++i) a.in[i] = (const float*)d_in[i];
    a.out = (float*)d_out; a.ws = ws;
    if (ONE_LAUNCH) { launch_mk(a, 0, (int)PH_FINAL, stream); return; }
    for (int ph = 0; ph < (int)PH_FINAL; ++ph) launch_mk(a, ph, ph + 1, stream);
}
```

```cpp
#include <hip/hip_runtime.h>
#include <cstdio>
#include <cstdint>

constexpr int BATCH = 2, T = 8192, D = 1024, M = BATCH * T, FF = 4096, PLE = 256;
constexpr int NQKV_A = 9216, NQKV_B = 3072;
constexpr float EPS = 1e-6f;
constexpr float LOG2E = 1.4426950408889634f;
constexpr float C2 = 0.125f * LOG2E;
constexpr int NWAVES_C = 8;
constexpr int GBT_N = 2048;

typedef unsigned short bf16;
typedef short bf16x8 __attribute__((ext_vector_type(8)));
typedef float f32x4 __attribute__((ext_vector_type(4)));
typedef unsigned v4u __attribute__((ext_vector_type(4)));
typedef unsigned v2u __attribute__((ext_vector_type(2)));
#define LAS __attribute__((address_space(3)))
#define GAS __attribute__((address_space(1)))

constexpr size_t MiB = 1u << 20;
constexpr size_t WS_CTL = 0, CTL_ZERO_BYTES = 1 * MiB;
constexpr size_t WS_GBT = 1 * MiB;
constexpr size_t WS_SSQ = 1 * MiB + 256 * 1024;
constexpr size_t SSQ_STRIDE = 256 * 1024;
constexpr size_t WS_LSE = 3 * MiB;
constexpr size_t WS_WA_QKV = 4 * MiB, WS_WA_O = 22 * MiB, WS_WB_QKV = 24 * MiB, WS_WB_O = 30 * MiB;
constexpr size_t WS_W1 = 32 * MiB, WS_W2 = 48 * MiB, WS_WG = 64 * MiB, WS_WP = 68 * MiB;
constexpr size_t WS_PB = 69 * MiB;
constexpr size_t WS_XA = 85 * MiB;
constexpr size_t WS_BIG = 128 * MiB;
constexpr size_t WS_QK = WS_BIG, WS_VT = WS_BIG + 64 * MiB, WS_MIX = WS_BIG + 96 * MiB;
constexpr size_t WS_QB = WS_BIG, WS_KB = WS_BIG + 32 * MiB, WS_VB = WS_BIG + 64 * MiB;
constexpr size_t WS_H = WS_BIG;
constexpr size_t WS_PROJ = WS_BIG;
constexpr size_t WS_END = 256 * MiB;

__device__ __forceinline__ unsigned f2bf(float f) { unsigned u = __builtin_bit_cast(unsigned, f); return (u + 0x7fffu + ((u >> 16) & 1u)) >> 16; }
__device__ __forceinline__ unsigned pk2(float lo, float hi) { return f2bf(lo) | (f2bf(hi) << 16); }
__device__ __forceinline__ float bf2f(unsigned short b) { return __builtin_bit_cast(float, (unsigned)b << 16); }
__device__ __forceinline__ float bflo(unsigned w) { return __builtin_bit_cast(float, w << 16); }
__device__ __forceinline__ float bfhi(unsigned w) { return __builtin_bit_cast(float, w & 0xffff0000u); }
__device__ __forceinline__ float wave_sum(float v) {
#pragma unroll
    for (int o = 1; o < 64; o <<= 1) v += __shfl_xor(v, o);
    return v;
}
__device__ __forceinline__ float wave_max(float v) {
#pragma unroll
    for (int o = 1; o < 64; o <<= 1) v = fmaxf(v, __shfl_xor(v, o));
    return v;
}
__device__ __forceinline__ int perm_to_token(int pos, int dil) {
    if (dil == 1) return pos;
    const int L = T / dil; const int b = pos / T, rem = pos % T, r = rem / L, s = rem % L; return b * T + s * dil + r;
}
__device__ __forceinline__ f32x4 ssq_raw(const float* ssq, int token) { return *(const f32x4*)(ssq + (size_t)token * 4); }
__device__ __forceinline__ float rstd_from(const f32x4 v) { return __builtin_amdgcn_rsqf(((v.x + v.y) + (v.z + v.w)) * (1.0f / D) + EPS); }
#define RAW8_FENCE(raw) asm volatile("" : "+v"(raw[0][0]), "+v"(raw[0][1]), "+v"(raw[0][2]), "+v"(raw[0][3]), "+v"(raw[1][0]), "+v"(raw[1][1]), "+v"(raw[1][2]), "+v"(raw[1][3]))
__device__ __forceinline__ float rstd_of(const float* ssq, int token) {
    const f32x4 v = *(const f32x4*)(ssq + (size_t)token * 4);
    return __builtin_amdgcn_rsqf(((v.x + v.y) + (v.z + v.w)) * (1.0f / D) + EPS);
}
__device__ __forceinline__ int rel_bucket(int n) {
    if (n < 16) return n;
    const float nf = (float)n;
    int large = 16 + (int)(logf(nf / 16.0f) / 4.852030263919617f * 16.0f);
    return large < 31 ? large : 31;
}

struct Args { const float* in[20]; float* out; unsigned char* ws; int ph_lo, ph_hi; };
__device__ __forceinline__ const float* karg_ptr(int byte_off) {
    GAS const float* p; auto ka = __builtin_amdgcn_kernarg_segment_ptr();
    asm volatile("s_load_dwordx2 %0, %1, %2\n\ts_waitcnt lgkmcnt(0)" : "=s"(p) : "s"(ka), "i"(byte_off) : "memory"); return (const float*)p;
}
#define AIN(i) karg_ptr(8 * (i))
#define AOUT ((float*)karg_ptr(160))
#define AWS ((unsigned char*)karg_ptr(168))

namespace pg8 {
#define PG8_LAS __attribute__((address_space(3)))
typedef unsigned short bf16_t;
typedef unsigned u32x4 __attribute__((ext_vector_type(4)));
constexpr int BM = 256, BK = 64, HALF = 128, HTB = HALF * BK * 2, STAGE_BYTES = 8 * HTB, NXCD = 8, WGM = 8;

__host__ __device__ __forceinline__ int lds_byte(int r, int c) { const int st = (r >> 4) * 2 + (c >> 5), rr = r & 15, cc = c & 31, ob = rr * 64 + cc * 2; return st * 1024 + (ob ^ (((ob >> 9) & 1) << 5)); }
__host__ __device__ __forceinline__ void stage_rc(int b, int& R, int& C) { const int st = b / 1024, sb = b % 1024, swz = sb ^ (((sb >> 9) & 1) << 5); R = (st >> 1) * 16 + swz / 64; C = (st & 1) * 32 + (swz % 64) / 2; }
__host__ __device__ __forceinline__ int perm32(int rho) { const int n = rho >> 4, i = rho & 15; return 8 * (i >> 2) + 4 * n + (i & 3); }

struct Unit { int pm, pn; };
struct Gemm { const bf16_t* A; const bf16_t* Bt; };

constexpr int GRID = 256;
template <int MR, int NC> struct StaticOrder {
    static constexpr int nM = MR / BM, nN = NC / BM, nwg = nM * nN;
    int c;
    __device__ __forceinline__ bool next(int i, Unit& u) const {
        const int L = i * GRID + c; if (L >= nwg) return false;
        int wgid = L; { constexpr int q = nwg / NXCD, r = nwg % NXCD; const int xcd = wgid % NXCD, off = wgid / NXCD; wgid = (xcd < r ? xcd * (q + 1) : r * (q + 1) + (xcd - r) * q) + off; }
        constexpr int nig = WGM * nN; const int gid = wgid / nig, fm = gid * WGM, gsz = (nM - fm) < WGM ? (nM - fm) : WGM;
        u.pm = fm + ((wgid % nig) % gsz); u.pn = (wgid % nig) / gsz; return true;
    }
};

typedef float f32x2_c __attribute__((ext_vector_type(2))); typedef __bf16 bf16x2_c __attribute__((ext_vector_type(2)));
__device__ __forceinline__ unsigned cvt_pk_bf16(float lo, float hi) { f32x2_c v = {lo, hi}; bf16x2_c b = __builtin_convertvector(v, bf16x2_c); return __builtin_bit_cast(unsigned, b); }

struct EpiRowScale {
    static constexpr bool PERM = true, AFTER_DRAIN = false, ROWSTAT = true; static constexpr int EPI_STORES = 16;
    bf16_t* O; int ldc; const float* ssq; int dil; int split; size_t split_stride; float scale0; int relu2; int kblk;
    __device__ __forceinline__ void preload(PG8_LAS float* sp, const Unit& u, int tid) const {
        if (ssq && tid < BM) sp[tid] = rstd_of(ssq, perm_to_token(u.pm * BM + tid, dil));
    }
    __device__ __forceinline__ void operator()(const f32x4 (&acc)[2][2][4][2], const Unit& u, int wr, int wc, int fr, int fq, const PG8_LAS float* sp) const {
        const int row0 = u.pm * BM + wr * 64 + fr; int colt = u.pn * BM; bf16_t* base = O;
        float sc = 1.f; bool kb = false; { const int t = colt >> 10; if (t == 0) sc = scale0; if (split) { base += (size_t)t * split_stride; colt -= t << 10; } kb = kblk != 0; }
        const int col0 = colt + wc * 32 + 8 * fq;
        float rsv[2][4];
#pragma unroll
        for (int ai = 0; ai < 2; ++ai)
#pragma unroll
            for (int m = 0; m < 4; ++m) rsv[ai][m] = ssq ? sp[wr * 64 + fr + ai * HALF + m * 16] * sc : sc;
#pragma unroll
        for (int ai = 0; ai < 2; ++ai)
#pragma unroll
            for (int m = 0; m < 4; ++m) { const int row = row0 + ai * HALF + m * 16; const float rs = rsv[ai][m];
                bf16_t* rowp = kb ? base + (((size_t)(row >> 5) * 16) * 8 * 32 + (row & 31)) * 8 : base + (size_t)row * ldc + col0;
#pragma unroll
                for (int bj = 0; bj < 2; ++bj) { f32x4 v0 = acc[ai][bj][m][0] * rs, v1 = acc[ai][bj][m][1] * rs;
                    if (relu2) { v0 = __builtin_elementwise_max(v0, (f32x4){0.f, 0.f, 0.f, 0.f}); v1 = __builtin_elementwise_max(v1, (f32x4){0.f, 0.f, 0.f, 0.f}); v0 = v0 * v0; v1 = v1 * v1; }
                    u32x4 w; w.x = cvt_pk_bf16(v0[0], v0[1]); w.y = cvt_pk_bf16(v0[2], v0[3]); w.z = cvt_pk_bf16(v1[0], v1[1]); w.w = cvt_pk_bf16(v1[2], v1[3]);
                    if (kb) { const int c8 = (col0 + bj * HALF) >> 3; *(u32x4*)(rowp + (size_t)c8 * 256) = w; }
                    else *(u32x4*)(rowp + bj * HALF) = w; } }
    }
};
struct EpiVT {
    static constexpr bool PERM = true, AFTER_DRAIN = false, ROWSTAT = true; static constexpr int EPI_STORES = 32;
    bf16_t* O; int ldc; const float* ssq; int dil;
    __device__ __forceinline__ void preload(PG8_LAS float* sp, const Unit& u, int tid) const {
        if (tid < BM) sp[tid] = rstd_of(ssq, perm_to_token(u.pn * BM + tid, dil));
    }
    __device__ __forceinline__ void operator()(const f32x4 (&acc)[2][2][4][2], const Unit& u, int wr, int wc, int fr, int fq, const PG8_LAS float* sp) const {
        const int row0 = u.pm * BM + wr * 64 + fr, col0 = u.pn * BM + wc * 32 + 8 * fq;
        f32x4 cs[2][2];
#pragma unroll
        for (int bj = 0; bj < 2; ++bj)
#pragma unroll
            for (int n = 0; n < 2; ++n) cs[bj][n] = *(const PG8_LAS f32x4*)(sp + wc * 32 + 8 * fq + bj * HALF + 4 * n);
#pragma unroll
        for (int ai = 0; ai < 2; ++ai)
#pragma unroll
            for (int m = 0; m < 4; ++m) {
                const int dg = row0 + ai * HALF + m * 16; const int head = dg >> 6, half = (dg >> 5) & 1, d31 = dg & 31;
#pragma unroll
                for (int bj = 0; bj < 2; ++bj) { const f32x4 v0 = acc[ai][bj][m][0] * cs[bj][0], v1 = acc[ai][bj][m][1] * cs[bj][1];
                    const int p0 = col0 + bj * HALF; const int tile = p0 >> 5, ks = (p0 >> 4) & 1, jh = (p0 >> 3) & 1;
                    bf16_t* fp = O + ((((((size_t)tile * 16 + head) * 2 + ks) * 2 + half) * 2) * 32 + d31) * 8 + jh * 4;
                    v2u w0, w1; w0.x = cvt_pk_bf16(v0[0], v0[1]); w0.y = cvt_pk_bf16(v0[2], v0[3]); w1.x = cvt_pk_bf16(v1[0], v1[1]); w1.y = cvt_pk_bf16(v1[2], v1[3]);
                    *(v2u*)fp = w0; *(v2u*)(fp + 256) = w1; } }
    }
};
template <bool BASE32, bool FINAL>
struct EpiRes {
    static constexpr bool PERM = true, AFTER_DRAIN = true, ROWSTAT = false; static constexpr int EPI_STORES = 0;
    const void* base; bf16_t* hout; float* ssq_out; const float* ssq_in; const bf16_t* proj; float* out; const float* gfin; unsigned* flags;
    __device__ __forceinline__ void fused(f32x4 (&acc)[2][2][4][2], const Unit& u, int wr, int wc, int fr, int fq, PG8_LAS unsigned char* lds, int wid, int lane) const {
        const int col0 = u.pn * BM + wc * 32 + 8 * fq;
        PG8_LAS float* P = (PG8_LAS float*)lds;
#pragma unroll
        for (int ai = 0; ai < 2; ++ai) {
            u32x4 bw[4][2], pw[4][2]; f32x4 bf0[4][2], bf1[4][2], rsr[4]; float rsm[4];
#pragma unroll
            for (int m = 0; m < 4; ++m) { const int grow = u.pm * BM + ai * HALF + wr * 64 + m * 16 + fr; const size_t off = (size_t)grow * D + col0;
#pragma unroll
                for (int bj = 0; bj < 2; ++bj) {
                    if constexpr (BASE32) { const f32x4* bp = (const f32x4*)((const float*)base + off + bj * HALF); bf0[m][bj] = bp[0]; bf1[m][bj] = bp[1]; }
                    else bw[m][bj] = *(const u32x4*)((const bf16_t*)base + off + bj * HALF);
                    if (proj) pw[m][bj] = *(const u32x4*)(proj + off + bj * HALF); }
                rsr[m] = (f32x4){1.f, 1.f, 1.f, 1.f}; if (proj) rsr[m] = ssq_raw(ssq_in, grow); }
            if constexpr (BASE32) asm volatile("" : "+v"(bf0[0][0]), "+v"(bf0[1][0]), "+v"(bf0[2][0]), "+v"(bf0[3][0]), "+v"(bf1[0][1]), "+v"(bf1[1][1]), "+v"(bf1[2][1]), "+v"(bf1[3][1]));
            else asm volatile("" : "+v"(bw[0][0]), "+v"(bw[1][0]), "+v"(bw[2][0]), "+v"(bw[3][0]), "+v"(bw[0][1]), "+v"(bw[1][1]), "+v"(bw[2][1]), "+v"(bw[3][1]));
            if (proj) asm volatile("" : "+v"(pw[0][0]), "+v"(pw[1][0]), "+v"(pw[2][0]), "+v"(pw[3][0]), "+v"(pw[0][1]), "+v"(pw[1][1]), "+v"(pw[2][1]), "+v"(pw[3][1]), "+v"(rsr[0]), "+v"(rsr[1]), "+v"(rsr[2]), "+v"(rsr[3]));
#pragma unroll
            for (int m = 0; m < 4; ++m) rsm[m] = proj ? rstd_from(rsr[m]) : 0.f;
#pragma unroll
            for (int m = 0; m < 4; ++m) { const int r = ai * HALF + wr * 64 + m * 16 + fr; const int grow = u.pm * BM + r; const size_t off = (size_t)grow * D + col0;
                const float rs = rsm[m];
                float s = 0.f;
#pragma unroll
                for (int bj = 0; bj < 2; ++bj) { f32x4 b0, b1;
                    if constexpr (BASE32) { b0 = bf0[m][bj]; b1 = bf1[m][bj]; }
                    else { const u32x4 w = bw[m][bj]; b0 = (f32x4){bflo(w.x), bfhi(w.x), bflo(w.y), bfhi(w.y)}; b1 = (f32x4){bflo(w.z), bfhi(w.z), bflo(w.w), bfhi(w.w)}; }
                    f32x4 a0 = acc[ai][bj][m][0], a1 = acc[ai][bj][m][1];
                    if (proj) { const u32x4 pr = pw[m][bj];
                        a0[0] = __builtin_amdgcn_rcpf(1.0f + __expf(-a0[0] * rs)) * bflo(pr.x); a0[1] = __builtin_amdgcn_rcpf(1.0f + __expf(-a0[1] * rs)) * bfhi(pr.x);
                        a0[2] = __builtin_amdgcn_rcpf(1.0f + __expf(-a0[2] * rs)) * bflo(pr.y); a0[3] = __builtin_amdgcn_rcpf(1.0f + __expf(-a0[3] * rs)) * bfhi(pr.y);
                        a1[0] = __builtin_amdgcn_rcpf(1.0f + __expf(-a1[0] * rs)) * bflo(pr.z); a1[1] = __builtin_amdgcn_rcpf(1.0f + __expf(-a1[1] * rs)) * bfhi(pr.z);
                        a1[2] = __builtin_amdgcn_rcpf(1.0f + __expf(-a1[2] * rs)) * bflo(pr.w); a1[3] = __builtin_amdgcn_rcpf(1.0f + __expf(-a1[3] * rs)) * bfhi(pr.w); }
                    const f32x4 h0 = b0 + a0, h1 = b1 + a1;
                    s += ((h0[0] * h0[0] + h0[1] * h0[1]) + (h0[2] * h0[2] + h0[3] * h0[3])) + ((h1[0] * h1[0] + h1[1] * h1[1]) + (h1[2] * h1[2] + h1[3] * h1[3]));
                    if constexpr (FINAL) { acc[ai][bj][m][0] = h0; acc[ai][bj][m][1] = h1; }
                    else { u32x4 w; w.x = cvt_pk_bf16(h0[0], h0[1]); w.y = cvt_pk_bf16(h0[2], h0[3]); w.z = cvt_pk_bf16(h1[0], h1[1]); w.w = cvt_pk_bf16(h1[2], h1[3]);
                        *(u32x4*)(hout + off + bj * HALF) = w; } }
                s += __shfl_xor(s, 16); s += __shfl_xor(s, 32);
                if (fq == 0) P[r * 4 + wc] = s; }
            asm volatile("" ::: "memory");
        }
        asm volatile("s_waitcnt lgkmcnt(0)" ::: "memory"); __builtin_amdgcn_s_barrier(); asm volatile("" ::: "memory");
        const int tid = wid * 64 + lane;
        if (tid < 256) { const f32x4 p = *(const PG8_LAS f32x4*)(P + tid * 4); ssq_out[(size_t)(u.pm * BM + tid) * 4 + u.pn] = (p[0] + p[1]) + (p[2] + p[3]); }
        if constexpr (FINAL) {
            asm volatile("s_waitcnt vmcnt(0) lgkmcnt(0)" ::: "memory"); __builtin_amdgcn_s_barrier(); asm volatile("" ::: "memory");
            if (tid == 0) {
                unsigned* fl = flags + u.pm * 16;
                __builtin_amdgcn_fence(__ATOMIC_RELEASE, "agent");
                __hip_atomic_fetch_add(fl, 1u, __ATOMIC_RELAXED, __HIP_MEMORY_SCOPE_AGENT);
                unsigned sp = 0;
                while (__hip_atomic_load(fl, __ATOMIC_RELAXED, __HIP_MEMORY_SCOPE_AGENT) < 4u) { __builtin_amdgcn_s_sleep(1); if (++sp > (1u << 22)) break; }
                __builtin_amdgcn_fence(__ATOMIC_ACQUIRE, "agent");
            }
            asm volatile("s_waitcnt vmcnt(0) lgkmcnt(0)" ::: "memory"); __builtin_amdgcn_s_barrier(); asm volatile("" ::: "memory");
            f32x4 gv[2][2];
#pragma unroll
            for (int bj = 0; bj < 2; ++bj) { const f32x4* gp = (const f32x4*)(gfin + col0 + bj * HALF); gv[bj][0] = gp[0]; gv[bj][1] = gp[1]; }
            float rfin[2][4];
            { f32x4 raw[2][4];
#pragma unroll
              for (int ai = 0; ai < 2; ++ai)
#pragma unroll
                for (int m = 0; m < 4; ++m) raw[ai][m] = ssq_raw(ssq_out, u.pm * BM + ai * HALF + wr * 64 + m * 16 + fr);
              RAW8_FENCE(raw);
#pragma unroll
              for (int ai = 0; ai < 2; ++ai)
#pragma unroll
                for (int m = 0; m < 4; ++m) rfin[ai][m] = rstd_from(raw[ai][m]); }
#pragma unroll
            for (int ai = 0; ai < 2; ++ai)
#pragma unroll
                for (int m = 0; m < 4; ++m) { const int grow = u.pm * BM + ai * HALF + wr * 64 + m * 16 + fr; const float rs = rfin[ai][m];
                    f32x4* op = (f32x4*)(out + (size_t)grow * D + col0);
#pragma unroll
                    for (int bj = 0; bj < 2; ++bj) { op[bj * (HALF / 4)] = acc[ai][bj][m][0] * rs * gv[bj][0]; op[bj * (HALF / 4) + 1] = acc[ai][bj][m][1] * rs * gv[bj][1]; } }
        }
        asm volatile("s_waitcnt lgkmcnt(0)" ::: "memory"); __builtin_amdgcn_s_barrier(); asm volatile("" ::: "memory");
    }
};

__device__ __forceinline__ size_t tile_row0(int tile, int dil) { return (size_t)perm_to_token(tile * BM, dil); }

template <class Epi, bool ALIGN_EPI, int MR, int NC, int K, int LDA, int LDB, int DILA, int DILB>
__device__ __forceinline__ void gemm_phase(PG8_LAS unsigned char* lds, const Gemm g, const Epi& E) {
    StaticOrder<MR, NC> S; S.c = (int)blockIdx.x;
    int tid_ = threadIdx.x; asm volatile("" : "+v"(tid_));
    const int tid = tid_, wid = __builtin_amdgcn_readfirstlane(tid >> 6), lane = tid & 63, wr = wid >> 2, wc = wid & 3, fr = lane & 15, fq = lane >> 4;
    constexpr int nt = K / BK;
    constexpr int pitchA = LDA * DILA, pitchB = LDB * DILB;
    unsigned voffA[2], voffB[2];
#pragma unroll
    for (int i = 0; i < 2; ++i) { int R, C; stage_rc(tid * 16 + i * 8192, R, C); const int Rb = Epi::PERM ? ((R & ~31) + perm32(R & 31)) : R;
        voffA[i] = (unsigned)(R * pitchA + C) * 2u; voffB[i] = (unsigned)(Rb * pitchB + C) * 2u; }
    constexpr size_t kstep = (size_t)(BK * 2);
    constexpr size_t hstepA = (size_t)HALF * pitchA * 2, hstepB = (size_t)HALF * pitchB * 2;
    const unsigned ldsw = (unsigned)wid * 1024u;
    const int aoff = lds_byte(wr * 64 + fr, fq * 8), boff = lds_byte(wc * 32 + fr, fq * 8);
#define PG8_SA(b, h) (((b) * 2 + (h)) * HTB)
#define PG8_SB(b, h) ((4 + (b) * 2 + (h)) * HTB)
#define PG8_STAGE(bufoff, gbase, voff) do { _Pragma("unroll") for (int _i = 0; _i < 2; ++_i) \
        __builtin_amdgcn_global_load_lds((const unsigned*)((const char*)(gbase) + (voff)[_i]), (PG8_LAS unsigned*)(lds + (bufoff) + ldsw + _i * 8192), 16, 0, 0); } while (0)
#define PG8_LDA(dst, b, h) do { _Pragma("unroll") for (int m = 0; m < 4; ++m) _Pragma("unroll") for (int k = 0; k < 2; ++k) dst[m][k] = *(const PG8_LAS bf16x8*)(lds + PG8_SA(b, h) + aoff + m * 2048 + k * 1024); } while (0)
#define PG8_LDB(dst, b, h) do { _Pragma("unroll") for (int n = 0; n < 2; ++n) _Pragma("unroll") for (int k = 0; k < 2; ++k) dst[n][k] = *(const PG8_LAS bf16x8*)(lds + PG8_SB(b, h) + boff + n * 2048 + k * 1024); } while (0)
#define PG8_MMA(ai, bj, At, Bt) do { __builtin_amdgcn_s_setprio(1); _Pragma("unroll") for (int m = 0; m < 4; ++m) _Pragma("unroll") for (int n = 0; n < 2; ++n) _Pragma("unroll") for (int k = 0; k < 2; ++k) \
        acc[ai][bj][m][n] = __builtin_amdgcn_mfma_f32_16x16x32_bf16(Bt[n][k], At[m][k], acc[ai][bj][m][n], 0, 0, 0); __builtin_amdgcn_s_setprio(0); } while (0)
#define PG8_WAIT_V(n) asm volatile("s_waitcnt vmcnt(" #n ")" ::: "memory")
#define PG8_WAIT_L(n) asm volatile("s_waitcnt lgkmcnt(" #n ")" ::: "memory")
#define PG8_BAR __builtin_amdgcn_s_barrier()
#define PG8_SCHED __builtin_amdgcn_sched_barrier(0)
#define PG8_ABASE(u) ((const char*)g.A + tile_row0((u).pm, DILA) * (size_t)LDA * 2)
#define PG8_BBASE(u) ((const char*)g.Bt + tile_row0((u).pn, DILB) * (size_t)LDB * 2)
    Unit cur, nxt; int ui = 0;
    if (!S.next(0, cur)) return;
    f32x4 acc[2][2][4][2];
#pragma unroll
    for (int a = 0; a < 2; ++a)
#pragma unroll
        for (int b = 0; b < 2; ++b)
#pragma unroll
            for (int m = 0; m < 4; ++m)
#pragma unroll
                for (int n = 0; n < 2; ++n) { acc[a][b][m][n] = (f32x4){0.f, 0.f, 0.f, 0.f}; asm volatile("" : "+v"(acc[a][b][m][n])); }
    bf16x8 At[4][2], B0[2][2], B1[2][2];
    const char* cA = PG8_ABASE(cur); const char* cB = PG8_BBASE(cur);
    PG8_STAGE(PG8_SB(0, 0), cB, voffB); PG8_STAGE(PG8_SB(0, 1), cB + hstepB, voffB); PG8_STAGE(PG8_SA(0, 0), cA, voffA); PG8_STAGE(PG8_SA(0, 1), cA + hstepA, voffA);
    PG8_LAS float* const sp = (PG8_LAS float*)(lds + STAGE_BYTES + 4096);
    if constexpr (Epi::ROWSTAT) E.preload(sp, cur, tid);
    if (wr == 1) PG8_BAR;
    PG8_WAIT_V(2); PG8_BAR;
    PG8_STAGE(PG8_SB(1, 0), cB + kstep, voffB); PG8_STAGE(PG8_SA(1, 0), cA + kstep, voffA); PG8_STAGE(PG8_SB(1, 1), cB + hstepB + kstep, voffB);
    PG8_WAIT_V(6); PG8_BAR;
#pragma unroll 1
    for (;;) {
        const bool has_next = S.next(ui + 1, nxt);
        const char* nA = has_next ? PG8_ABASE(nxt) : cA; const char* nB = has_next ? PG8_BBASE(nxt) : cB;
#pragma unroll 1
        for (int t = 0; t < nt; t += 2) {
            const bool last = (t == nt - 2);
            const char* a1 = cA + (size_t)(t + 1) * kstep;
            const char* a2 = last ? nA : cA + (size_t)(t + 2) * kstep; const char* b2 = last ? nB : cB + (size_t)(t + 2) * kstep;
            const char* a3 = a2 + kstep; const char* b3 = b2 + kstep;
            const bool lenient = !Epi::AFTER_DRAIN && Epi::EPI_STORES == 16 && t == 0 && ui > 0;
            PG8_LDB(B0, 0, 0); PG8_LDB(B1, 0, 1); PG8_SCHED; PG8_LDA(At, 0, 0); PG8_STAGE(PG8_SA(1, 1), a1 + hstepA, voffA);
            if (lenient) PG8_WAIT_V(24); else PG8_WAIT_V(8);
            PG8_WAIT_L(0); PG8_BAR; PG8_MMA(0, 0, At, B0); PG8_MMA(0, 1, At, B1); PG8_BAR; PG8_SCHED;
            PG8_LDA(At, 0, 1); PG8_STAGE(PG8_SB(0, 0), b2, voffB); PG8_STAGE(PG8_SB(0, 1), b2 + hstepB, voffB); PG8_STAGE(PG8_SA(0, 0), a2, voffA);
            if (lenient) PG8_WAIT_V(24); else PG8_WAIT_V(8);
            PG8_WAIT_L(0); PG8_BAR; PG8_MMA(1, 0, At, B0); PG8_MMA(1, 1, At, B1); PG8_BAR; PG8_SCHED;
            PG8_LDB(B0, 1, 0); PG8_LDB(B1, 1, 1); PG8_SCHED; PG8_LDA(At, 1, 0); PG8_STAGE(PG8_SA(0, 1), a2 + hstepA, voffA);
            PG8_WAIT_V(8); PG8_WAIT_L(0); PG8_BAR; PG8_MMA(0, 0, At, B0); PG8_MMA(0, 1, At, B1); PG8_BAR; PG8_SCHED;
            PG8_LDA(At, 1, 1); PG8_STAGE(PG8_SB(1, 0), b3, voffB); PG8_STAGE(PG8_SB(1, 1), b3 + hstepB, voffB); PG8_STAGE(PG8_SA(1, 0), a3, voffA);
            PG8_WAIT_V(8); PG8_WAIT_L(0); PG8_BAR; PG8_MMA(1, 0, At, B0); PG8_MMA(1, 1, At, B1); PG8_BAR; PG8_SCHED;
        }
        if constexpr (ALIGN_EPI) { if (wr == 0) PG8_BAR; }
        if constexpr (!Epi::AFTER_DRAIN) { E(acc, cur, wr, wc, fr, fq, sp); }
        if (!has_next) break;
#pragma unroll
        for (int a = 0; a < 2; ++a)
#pragma unroll
            for (int b = 0; b < 2; ++b)
#pragma unroll
                for (int m = 0; m < 4; ++m)
#pragma unroll
                    for (int n = 0; n < 2; ++n) { acc[a][b][m][n] = (f32x4){0.f, 0.f, 0.f, 0.f}; asm volatile("" : "+v"(acc[a][b][m][n])); }
        cur = nxt; cA = nA; cB = nB; ++ui;
        if constexpr (ALIGN_EPI) { if (wr == 1) PG8_BAR; }
    }
    PG8_WAIT_V(0);
    if constexpr (!ALIGN_EPI) { if (wr == 0) PG8_BAR; }
    PG8_BAR;
    if constexpr (Epi::AFTER_DRAIN) { E.fused(acc, cur, wr, wc, fr, fq, lds, wid, lane); }
#undef PG8_SA
#undef PG8_SB
#undef PG8_STAGE
#undef PG8_LDA
#undef PG8_LDB
#undef PG8_MMA
#undef PG8_WAIT_V
#undef PG8_WAIT_L
#undef PG8_BAR
#undef PG8_SCHED
#undef PG8_ABASE
#undef PG8_BBASE
}
}


#include <hip/hip_bf16.h>
namespace att {
using bf16h = __hip_bfloat16;
using s16x4 = __attribute__((ext_vector_type(4))) short;
using f32x16 = __attribute__((ext_vector_type(16))) float;
using u32x4 = __attribute__((ext_vector_type(4))) unsigned;
constexpr int DM = 1024, NW = 8, QBLK = 32, QB = QBLK * NW, KVBLK = 64;
constexpr int NSLOT = 3, SLOTB = 8192;
constexpr int LDS_K = 0, LDS_V = NSLOT * SLOTB, LDS_WS = 2 * NSLOT * SLOTB, LDS_OST = LDS_WS + NW * 64 * 4;
constexpr int GUARD = 256;
constexpr float MASKV = -__builtin_huge_valf();
template <int MODE> struct Geo {
    static constexpr int OST_BYTES = MODE == 0 ? NW * 4096 : NW * 8192;
    static constexpr int LDS_TBL = LDS_OST + OST_BYTES;
    static constexpr int NTBL = MODE == 0 ? GUARD + 8192 : GUARD + 384;
    static constexpr int LDS_END = LDS_TBL + NTBL * 4;
};
static_assert(Geo<0>::LDS_END <= 131072 && Geo<1>::LDS_END <= 131072, "attention LDS map");
__device__ __forceinline__ int crow(int r, int hi) { return (r & 3) + 8 * (r >> 2) + 4 * hi; }
#define SBAR() __builtin_amdgcn_sched_barrier(0)
__device__ __forceinline__ void glds16(const void* gsrc, unsigned lds_dst) { unsigned keep;
    asm volatile("s_mov_b32 %0, m0\n\ts_mov_b32 m0, %2\n\ts_nop 0\n\tglobal_load_lds_dwordx4 %1, off\n\ts_mov_b32 m0, %0" : "=&s"(keep) : "v"(gsrc), "s"(lds_dst) : "memory"); }
__device__ __forceinline__ float max3f(float a, float b, float c) { float r; asm("v_max3_f32 %0, %1, %2, %3" : "=v"(r) : "v"(a), "v"(b), "v"(c)); return r; }
__device__ __forceinline__ float max2f(float a, float b) { float r; asm("v_max_f32_e32 %0, %1, %2" : "=v"(r) : "v"(a), "v"(b)); return r; }
__device__ __forceinline__ float fadd_s(float a, float b) { float r; asm("v_add_f32_e32 %0, %1, %2" : "=v"(r) : "v"(a), "v"(b)); return r; }
__device__ __forceinline__ float fsub_s(float a, float b) { float r; asm("v_sub_f32_e32 %0, %1, %2" : "=v"(r) : "v"(a), "v"(b)); return r; }
typedef float f32x2_t __attribute__((ext_vector_type(2))); typedef __bf16 bf16x2_t __attribute__((ext_vector_type(2)));
__device__ __forceinline__ unsigned cvtpk_s(float lo, float hi) { f32x2_t v = {lo, hi}; bf16x2_t b = __builtin_convertvector(v, bf16x2_t); return __builtin_bit_cast(unsigned, b); }
#define WAIT_BAR(N) asm volatile("s_waitcnt vmcnt(" #N ") lgkmcnt(0)\n\ts_barrier" ::: "memory")
typedef __attribute__((address_space(3))) const char* lds_cptr;
typedef __attribute__((address_space(3))) char* lds_ptr;
#define ALDS __attribute__((address_space(3)))
typedef short v4i16_t __attribute__((ext_vector_type(4)));

__device__ __forceinline__ void qkt(f32x16& p0, f32x16& p1, lds_cptr Kslot, const bf16x8* qr, const f32x16& negm, int r32, int hi) {
    lds_cptr kb = Kslot + hi * 1024 + r32 * 16;
#pragma unroll
    for (int d0 = 0; d0 < 4; ++d0) {
        const bf16x8 b0 = *(const ALDS bf16x8*)(kb + d0 * 2048);
        const bf16x8 b1 = *(const ALDS bf16x8*)(kb + d0 * 2048 + 512);
        if (d0 == 0) { p0 = __builtin_amdgcn_mfma_f32_32x32x16_bf16(b0, qr[0], negm, 0, 0, 0); p1 = __builtin_amdgcn_mfma_f32_32x32x16_bf16(b1, qr[0], negm, 0, 0, 0); }
        else { p0 = __builtin_amdgcn_mfma_f32_32x32x16_bf16(b0, qr[d0], p0, 0, 0, 0); p1 = __builtin_amdgcn_mfma_f32_32x32x16_bf16(b1, qr[d0], p1, 0, 0, 0); } }
}
__device__ __forceinline__ void kload8(bf16x8* kf, lds_cptr kp) {
    kf[0] = *(const __attribute__((address_space(3))) bf16x8*)(kp);        kf[1] = *(const __attribute__((address_space(3))) bf16x8*)(kp + 512);
    kf[2] = *(const __attribute__((address_space(3))) bf16x8*)(kp + 2048); kf[3] = *(const __attribute__((address_space(3))) bf16x8*)(kp + 2560);
    kf[4] = *(const __attribute__((address_space(3))) bf16x8*)(kp + 4096); kf[5] = *(const __attribute__((address_space(3))) bf16x8*)(kp + 4608);
    kf[6] = *(const __attribute__((address_space(3))) bf16x8*)(kp + 6144); kf[7] = *(const __attribute__((address_space(3))) bf16x8*)(kp + 6656);
}
__device__ __forceinline__ void kload2(bf16x8* kf, lds_cptr kp, int j) { kf[2 * j] = *(const __attribute__((address_space(3))) bf16x8*)(kp + j * 2048); kf[2 * j + 1] = *(const __attribute__((address_space(3))) bf16x8*)(kp + j * 2048 + 512); }
__device__ __forceinline__ s16x4 vtr(lds_cptr p) { return __builtin_bit_cast(s16x4, __builtin_amdgcn_ds_read_tr16_b64_v4i16((__attribute__((address_space(3))) v4i16_t*)p)); }
__device__ __forceinline__ float rowmax(const f32x16& p0, const f32x16& p1) {
    float a = max3f(p0[0], p0[1], p1[0]), b = max3f(p0[2], p0[3], p1[1]); a = max3f(a, p1[2], p1[3]);
#pragma unroll
    for (int r = 4; r < 16; r += 4) { a = max3f(a, p0[r], p0[r + 1]); b = max3f(b, p0[r + 2], p0[r + 3]); a = max3f(a, p1[r], p1[r + 1]); b = max3f(b, p1[r + 2], p1[r + 3]); }
    const float m = max2f(a, b);
    auto rr = __builtin_amdgcn_permlane32_swap(__float_as_uint(m), __float_as_uint(m), false, false);
    return max2f(__uint_as_float(rr[0]), __uint_as_float(rr[1]));
}
__device__ __forceinline__ void pv(f32x16* o, int vb, bf16x8 pa0, bf16x8 pa1, bf16x8 pa2, bf16x8 pa3) {
#pragma unroll
    for (int d0 = 0; d0 < 2; ++d0) { s16x4 lo[4], hi[4];
#pragma unroll
        for (int ks = 0; ks < 4; ++ks) {
            asm volatile("ds_read_b64_tr_b16 %0,%1 offset:%c2" : "=&v"(lo[ks]) : "v"(vb), "i"(d0 * 4096 + ks * 1024) : "memory");
            asm volatile("ds_read_b64_tr_b16 %0,%1 offset:%c2" : "=&v"(hi[ks]) : "v"(vb), "i"(d0 * 4096 + ks * 1024 + 512) : "memory"); }
        asm volatile("s_waitcnt lgkmcnt(0)" ::: "memory"); SBAR();
#define PK(k) (bf16x8){lo[k][0], lo[k][1], lo[k][2], lo[k][3], hi[k][0], hi[k][1], hi[k][2], hi[k][3]}
        o[d0] = __builtin_amdgcn_mfma_f32_32x32x16_bf16(pa0, PK(0), o[d0], 0, 0, 0);
        o[d0] = __builtin_amdgcn_mfma_f32_32x32x16_bf16(pa1, PK(1), o[d0], 0, 0, 0);
        o[d0] = __builtin_amdgcn_mfma_f32_32x32x16_bf16(pa2, PK(2), o[d0], 0, 0, 0);
        o[d0] = __builtin_amdgcn_mfma_f32_32x32x16_bf16(pa3, PK(3), o[d0], 0, 0, 0);
#undef PK
    }
}

struct UnitDesc {
    const bf16h* Q; const bf16h* K; const bf16h* V;
    int q0, kt0, NT;
    int NT_far; float cfar; int tbl_off;
    int comb;
    bf16h* O;
    bf16h* MIXp; float* LSEp; int tok0, dil, g;
};

template <int MODE, int THRL> __device__ __forceinline__ void attn_unit(const UnitDesc& U, lds_ptr shm) {
    int tid_ = threadIdx.x; asm volatile("" : "+v"(tid_));
    const int tid = tid_, lane = tid & 63, r32 = lane & 31, hi = lane >> 5; const int wid = __builtin_amdgcn_readfirstlane(tid >> 6);
    const int q0 = U.q0;
    const bf16h* Qw = U.Q + (long)(q0 + wid * QBLK) * DM;
    const bf16h* Kh = U.K + (long)U.kt0 * KVBLK * DM; const bf16h* Vh = U.V + (long)U.kt0 * KVBLK * DM;
    const unsigned lds0 = (unsigned)(uintptr_t)shm;
    ALDS float* wsf = (ALDS float*)(shm + LDS_WS) + wid * 64;
    const bf16h* ksrc = Kh + (long)lane * DM + wid * 8;
    const bf16h* vsrc = Vh + (long)(16 * (wid & 3) + (lane >> 2)) * DM + (wid >> 2) * 32 + (lane & 3) * 8;
    const unsigned kdst = lds0 + LDS_K + wid * 1024, vdst = lds0 + LDS_V + wid * 1024;
#define DMA_K(t, slot) glds16(ksrc + (long)(t) * KVBLK * DM, (unsigned)__builtin_amdgcn_readfirstlane(kdst + (slot)))
#define DMA_V(t, slot) glds16(vsrc + (long)(t) * KVBLK * DM, (unsigned)__builtin_amdgcn_readfirstlane(vdst + (slot)))
    const int vb0 = (int)(lds0 + LDS_V) + ((lane >> 4) & 1) * 32 + (lane & 3) * 8 + (4 * hi + ((lane & 15) >> 2)) * 64;
    const lds_cptr Kbase = shm + LDS_K; bf16x8 kf[8];
    const lds_cptr shm3 = (lds_cptr)shm; const lds_cptr kp0 = shm3 + LDS_K + hi * 1024 + r32 * 16; const lds_cptr vp0 = shm3 + LDS_V + ((lane >> 4) & 1) * 32 + (lane & 3) * 8 + (4 * hi + ((lane & 15) >> 2)) * 64;
    const lds_cptr tb0 = shm3 + Geo<MODE>::LDS_TBL + 4 * (GUARD - 59 + (q0 - KVBLK * U.kt0) + QBLK * wid + r32 - 4 * hi);
    const int NT = U.NT;
    DMA_K(0, 0); DMA_V(0, 0); DMA_K(1, SLOTB);
    bf16x8 qr[4];
#pragma unroll
    for (int d0 = 0; d0 < 4; ++d0) qr[d0] = *reinterpret_cast<const bf16x8*>(&Qw[(long)r32 * DM + d0 * 16 + hi * 8]);
    float mhat = 0.f, l_reg = 0.f; f32x16 o[2]; o[0] = f32x16{}; o[1] = f32x16{}; asm volatile("" : "+v"(o[0]), "+v"(o[1]));
    const int NT_far = U.NT_far; float cb = NT_far > 0 ? U.cfar : 0.f;
    f32x16 negm; _Pragma("unroll") for (int r = 0; r < 16; ++r) negm[r] = cb; asm volatile("" : "+v"(negm));
#define BIAS(P0, P1, T0, T1, t) do { const ALDS float* tb_ = (const ALDS float*)(tb0 - 256 * (t)); \
    _Pragma("unroll") for (int r = 0; r < 16; ++r) T0[r] = tb_[59 - ((r & 3) + 8 * (r >> 2))]; \
    asm volatile("s_waitcnt lgkmcnt(0)" : "+v"(T0) :: "memory"); \
    _Pragma("unroll") for (int r = 0; r < 16; ++r) P0[r] += T0[r]; \
    _Pragma("unroll") for (int r = 0; r < 16; ++r) T0[r] = tb_[27 - ((r & 3) + 8 * (r >> 2))]; \
    asm volatile("s_waitcnt lgkmcnt(0)" : "+v"(T0) :: "memory"); \
    _Pragma("unroll") for (int r = 0; r < 16; ++r) P1[r] += T0[r]; } while (0)
    bool resc = false;
#define START(P0, P1) do { const float rm = rowmax(P0, P1); resc = false; \
    { const float dl = rm < -1e30f ? 0.f : rm; mhat = fadd_s(mhat, dl); \
      _Pragma("unroll") for (int r = 0; r < 16; ++r) { P0[r] = fsub_s(P0[r], dl); P1[r] = fsub_s(P1[r], dl); } \
      _Pragma("unroll") for (int r = 0; r < 16; ++r) negm[r] = cb - mhat; asm volatile("" : "+v"(negm)); } \
    _Pragma("unroll") for (int r = 0; r < 16; ++r) P0[r] = __builtin_amdgcn_exp2f(P0[r]); } while (0)
#define RESC() do { if (resc) { asm volatile("s_waitcnt lgkmcnt(0)" ::: "memory"); \
      _Pragma("unroll") for (int d_ = 0; d_ < 2; ++d_) _Pragma("unroll") for (int r = 0; r < 16; ++r) o[d_][r] *= wsf[crow(r, hi)]; } } while (0)
    f32x16 pA0, pA1, pB0, pB1;
    int sl_prev = 0, sl_cur = 0, sl_next = SLOTB;
#define ROT() do { sl_prev = sl_cur; sl_cur = sl_next; sl_next = (sl_next == (NSLOT - 1) * SLOTB) ? 0 : sl_next + SLOTB; } while (0)
#define NEARCHK(tn) do { if ((tn) == NT_far) { cb = 0.f; _Pragma("unroll") for (int r = 0; r < 16; ++r) negm[r] = -mhat; asm volatile("" : "+v"(negm)); } } while (0)
    DMA_K(2, 2 * SLOTB);
    WAIT_BAR(3);
    qkt(pA0, pA1, Kbase, qr, negm, r32, hi); asm volatile("s_nop 15\n\ts_nop 7" : "+v"(pA0), "+v"(pA1)); if (NT_far == 0) BIAS(pA0, pA1, pB0, pB1, 0);
    START(pA0, pA1);
    _Pragma("unroll") for (int r = 0; r < 16; ++r) pA1[r] = __builtin_amdgcn_exp2f(pA1[r]);
    WAIT_BAR(0);
    DMA_K(3, 0); DMA_V(1, SLOTB);
    ROT(); NEARCHK(1);
    kload8(kf, kp0 + sl_cur);
    WAIT_BAR(2);
    s16x4 vlo[8], vhi[8]; u32x4 pw0, pw1, pw2, pw3;
#define PKW(P, B) cvtpk_s(P[B], P[B + 1])
#define PAF(k) __builtin_bit_cast(bf16x8, pw##k)
#define VFR(i) (bf16x8){vlo[i][0], vlo[i][1], vlo[i][2], vlo[i][3], vhi[i][0], vhi[i][1], vhi[i][2], vhi[i][3]}
#define PIN(x) asm volatile("" : "+v"(x))
#define MX3(a, b, c) __builtin_fmaxf(__builtin_fmaxf((a), (b)), (c))
#define GAPA(MF, A0, A1, A2, A3, W0, W1, PW) do { MF; sacc += A0; sacc += A1; sacc += A2; sacc += A3; PIN(sacc); W0; W1; PIN(PW); SBAR(); } while (0)
#define EX(v) __builtin_amdgcn_exp2f(v)
#define GAPB(MF, X, B) do { MF; X[B] = EX(X[B]); X[B + 1] = EX(X[B + 1]); X[B + 2] = EX(X[B + 2]); X[B + 3] = EX(X[B + 3]); PIN(X); SBAR(); } while (0)
#define VRD(i) do { vlo[i] = vtr(vp_ + (((i) >> 2) * 4096 + ((i) & 3) * 1024)); vhi[i] = vtr(vp_ + (((i) >> 2) * 4096 + ((i) & 3) * 1024 + 512)); } while (0)
#define KRD(G, j) do { if (G) { kload2(kf, kp0 + sl_next, j); SBAR(); } } while (0)
#define STEP(C0, C1, P0, P1, t, GK, GV, GL) do { SBAR(); \
    const lds_cptr vp_ = vp0 + sl_prev; \
    VRD(0); SBAR(); float sacc = (P0[0] + P0[1]); \
    GAPA(C0 = __builtin_amdgcn_mfma_f32_32x32x16_bf16(kf[0], qr[0], negm, 0, 0, 0), P0[2], P0[3], P0[4], P0[5],     pw0[0] = PKW(P0, 0), pw0[1] = PKW(P0, 2), pw0); \
    VRD(4); SBAR(); GAPA(C1 = __builtin_amdgcn_mfma_f32_32x32x16_bf16(kf[1], qr[0], negm, 0, 0, 0), P0[6], P0[7], P0[8], P0[9],     pw0[2] = PKW(P0, 4), pw0[3] = PKW(P0, 6), pw0); \
    VRD(1); SBAR(); GAPA(C0 = __builtin_amdgcn_mfma_f32_32x32x16_bf16(kf[2], qr[1], C0, 0, 0, 0),   P0[10], P0[11], P0[12], P0[13], pw1[0] = PKW(P0, 8), pw1[1] = PKW(P0, 10), pw1); \
    VRD(5); SBAR(); GAPA(C1 = __builtin_amdgcn_mfma_f32_32x32x16_bf16(kf[3], qr[1], C1, 0, 0, 0),   P0[14], P0[15], P1[0], P1[1],   pw1[2] = PKW(P0, 12), pw1[3] = PKW(P0, 14), pw1); \
    VRD(2); SBAR(); GAPA(C0 = __builtin_amdgcn_mfma_f32_32x32x16_bf16(kf[4], qr[2], C0, 0, 0, 0),   P1[2], P1[3], P1[4], P1[5],     pw2[0] = PKW(P1, 0), pw2[1] = PKW(P1, 2), pw2); \
    VRD(6); SBAR(); GAPA(C1 = __builtin_amdgcn_mfma_f32_32x32x16_bf16(kf[5], qr[2], C1, 0, 0, 0),   P1[6], P1[7], P1[8], P1[9],     pw2[2] = PKW(P1, 4), pw2[3] = PKW(P1, 6), pw2); \
    VRD(3); SBAR(); GAPA(C0 = __builtin_amdgcn_mfma_f32_32x32x16_bf16(kf[6], qr[3], C0, 0, 0, 0),   P1[10], P1[11], P1[12], P1[13], pw3[0] = PKW(P1, 8), pw3[1] = PKW(P1, 10), pw3); \
    VRD(7); SBAR(); GAPA(C1 = __builtin_amdgcn_mfma_f32_32x32x16_bf16(kf[7], qr[3], C1, 0, 0, 0),   P1[14], P1[15], 0.f, 0.f,       pw3[2] = PKW(P1, 12), pw3[3] = PKW(P1, 14), pw3); \
    l_reg += sacc; \
    if (GK) { DMA_K((t) + 3, sl_cur); } if (GV) { DMA_V((t) + 1, sl_next); } \
    if ((t) >= NT_far) BIAS(C0, C1, P0, P1, t); \
    { float a = MX3(C0[0], C0[1], C1[0]), b = MX3(C0[2], C0[3], C1[1]); a = MX3(a, C1[2], C1[3]); \
      _Pragma("unroll") for (int r = 4; r < 16; r += 4) { a = MX3(a, C0[r], C0[r + 1]); b = MX3(b, C0[r + 2], C0[r + 3]); a = MX3(a, C1[r], C1[r + 1]); b = MX3(b, C1[r + 2], C1[r + 3]); } \
      float rm = __builtin_fmaxf(a, b); { auto rr = __builtin_amdgcn_permlane32_swap(__float_as_uint(rm), __float_as_uint(rm), false, false); rm = __builtin_fmaxf(__uint_as_float(rr[0]), __uint_as_float(rr[1])); } \
      resc = false; \
      if (__builtin_expect(__any(rm > (float)THRL), 0)) { const float dl = __builtin_fmaxf(rm, 0.f); mhat += dl; \
        _Pragma("unroll") for (int r = 0; r < 16; ++r) { C0[r] -= dl; C1[r] -= dl; } \
        _Pragma("unroll") for (int r = 0; r < 16; ++r) negm[r] = cb - mhat; asm volatile("" : "+v"(negm)); \
        const float f = __builtin_amdgcn_exp2f(-dl); l_reg *= f; if (hi == 0) wsf[r32] = f; resc = true; } } \
    SBAR(); \
    GAPB(o[0] = __builtin_amdgcn_mfma_f32_32x32x16_bf16(PAF(0), VFR(0), o[0], 0, 0, 0), C0, 0); \
    GAPB(o[1] = __builtin_amdgcn_mfma_f32_32x32x16_bf16(PAF(0), VFR(4), o[1], 0, 0, 0), C0, 4); \
    KRD(GL, 0); GAPB(o[0] = __builtin_amdgcn_mfma_f32_32x32x16_bf16(PAF(1), VFR(1), o[0], 0, 0, 0), C0, 8); \
    KRD(GL, 1); GAPB(o[1] = __builtin_amdgcn_mfma_f32_32x32x16_bf16(PAF(1), VFR(5), o[1], 0, 0, 0), C0, 12); \
    KRD(GL, 2); GAPB(o[0] = __builtin_amdgcn_mfma_f32_32x32x16_bf16(PAF(2), VFR(2), o[0], 0, 0, 0), C1, 0); \
    KRD(GL, 3); GAPB(o[1] = __builtin_amdgcn_mfma_f32_32x32x16_bf16(PAF(2), VFR(6), o[1], 0, 0, 0), C1, 4); \
    GAPB(o[0] = __builtin_amdgcn_mfma_f32_32x32x16_bf16(PAF(3), VFR(3), o[0], 0, 0, 0), C1, 8); \
    GAPB(o[1] = __builtin_amdgcn_mfma_f32_32x32x16_bf16(PAF(3), VFR(7), o[1], 0, 0, 0), C1, 12); \
    } while (0)
    int t = 1;
    for (; t + 5 < NT; t += 2) {
        STEP(pB0, pB1, pA0, pA1, t, true, true, true);     WAIT_BAR(2); RESC(); ROT(); NEARCHK(t + 1);
        STEP(pA0, pA1, pB0, pB1, t + 1, true, true, true); WAIT_BAR(2); RESC(); ROT(); NEARCHK(t + 2);
    }
#define ENDW(tt) do { if ((tt) + 3 < NT) { WAIT_BAR(2); } else if ((tt) + 2 < NT) { WAIT_BAR(1); } else { WAIT_BAR(0); } } while (0)
    for (; t + 1 < NT; t += 2) {
        STEP(pB0, pB1, pA0, pA1, t, (t + 3 < NT), (t + 1 < NT), (t + 1 < NT));         ENDW(t);     RESC(); ROT(); NEARCHK(t + 1);
        STEP(pA0, pA1, pB0, pB1, t + 1, (t + 4 < NT), (t + 2 < NT), (t + 2 < NT));     ENDW(t + 1); RESC(); ROT(); NEARCHK(t + 2);
    }
    STEP(pB0, pB1, pA0, pA1, NT - 1, false, false, false); RESC();
    { float sacc = pB0[0] + pB0[1]; _Pragma("unroll") for (int r = 2; r < 16; ++r) sacc += pB0[r]; _Pragma("unroll") for (int r = 0; r < 16; ++r) sacc += pB1[r]; l_reg += sacc;
      pw0 = (u32x4){PKW(pB0, 0), PKW(pB0, 2), PKW(pB0, 4), PKW(pB0, 6)}; pw1 = (u32x4){PKW(pB0, 8), PKW(pB0, 10), PKW(pB0, 12), PKW(pB0, 14)}; pw2 = (u32x4){PKW(pB1, 0), PKW(pB1, 2), PKW(pB1, 4), PKW(pB1, 6)}; pw3 = (u32x4){PKW(pB1, 8), PKW(pB1, 10), PKW(pB1, 12), PKW(pB1, 14)};
      SBAR(); pv(o, vb0 + sl_cur, PAF(0), PAF(1), PAF(2), PAF(3)); }
#undef PKW
#undef PAF
#undef VFR
#undef PIN
#undef MX3
#undef GAPA
#undef GAPB
#undef EX
#undef VRD
#undef KRD
#undef STEP
#undef ENDW
    int tidE = threadIdx.x; asm volatile("" : "+v"(tidE)); const int laneE = tidE & 63, r32E = laneE & 31, hiE = laneE >> 5;
    { auto rr = __builtin_amdgcn_permlane32_swap(__float_as_uint(l_reg), __float_as_uint(l_reg), false, false); l_reg = __uint_as_float(rr[0]) + __uint_as_float(rr[1]); }
    if constexpr (MODE == 0) {
        if (hiE == 0) wsf[32 + r32E] = l_reg; asm volatile("s_waitcnt lgkmcnt(0)" ::: "memory");
        float rli[16];
#pragma unroll
        for (int r = 0; r < 16; ++r) rli[r] = __builtin_amdgcn_rcpf(wsf[32 + crow(r, hiE)]);
        bf16h* Ow = U.O + (long)(q0 + wid * QBLK) * DM;
        ALDS unsigned short* stg = (ALDS unsigned short*)(shm + LDS_OST) + wid * 2048;
#pragma unroll
        for (int r = 0; r < 16; ++r) { const int orow = crow(r, hiE);
#pragma unroll
            for (int d0 = 0; d0 < 2; ++d0) stg[orow * 64 + d0 * 32 + r32E] = __builtin_bit_cast(unsigned short, (__bf16)(o[d0][r] * rli[r])); }
        asm volatile("s_waitcnt lgkmcnt(0)" ::: "memory");
#pragma unroll
        for (int i = 0; i < 4; ++i) { const int row = i * 8 + (laneE >> 3), ch = laneE & 7; const u32x4 v = *(const ALDS u32x4*)(stg + row * 64 + ch * 8); *(u32x4*)(Ow + (long)row * DM + ch * 8) = v; }
    } else {
        const int srow = q0 + wid * QBLK + r32E; const long tok = (long)U.tok0 + (long)srow * U.dil;
        float lse_g = mhat + __builtin_amdgcn_logf(l_reg);
        float ca = 0.f, cg = __builtin_amdgcn_rcpf(l_reg), lse_new = lse_g;
        if (U.g > 0) { const float la = U.LSEp[tok * 16]; const float Mx = __builtin_fmaxf(la, lse_g); const float wa = __builtin_amdgcn_exp2f(la - Mx), wg = __builtin_amdgcn_exp2f(lse_g - Mx);
            const float inv = __builtin_amdgcn_rcpf(wa + wg); ca = wa * inv; cg = wg * inv * cg; lse_new = Mx + __builtin_amdgcn_logf(wa + wg); }
        if (hiE == 0) { wsf[r32E] = ca; wsf[32 + r32E] = cg; U.LSEp[tok * 16] = lse_new; }
        asm volatile("s_waitcnt lgkmcnt(0)" ::: "memory");
        ALDS float* stg = (ALDS float*)(shm + LDS_OST) + wid * 2048;
#pragma unroll
        for (int r = 0; r < 16; ++r) { const int orow = crow(r, hiE); const float sc = wsf[32 + orow];
#pragma unroll
            for (int d0 = 0; d0 < 2; ++d0) stg[orow * 64 + d0 * 32 + r32E] = o[d0][r] * sc; }
        asm volatile("s_waitcnt lgkmcnt(0)" ::: "memory");
#pragma unroll
        for (int i = 0; i < 4; ++i) { const int row = i * 8 + (laneE >> 3), ch = laneE & 7;
            const f32x4 a0 = *(const ALDS f32x4*)(stg + row * 64 + ch * 8), a1 = *(const ALDS f32x4*)(stg + row * 64 + ch * 8 + 4);
            bf16h* mp = U.MIXp + ((long)U.tok0 + (long)(q0 + wid * QBLK + row) * U.dil) * DM + ch * 8;
            f32x4 r0 = a0, r1 = a1;
            if (U.g > 0) { const float car = wsf[row]; const u32x4 pv_ = *(const u32x4*)mp;
                r0[0] += car * bflo(pv_.x); r0[1] += car * bfhi(pv_.x); r0[2] += car * bflo(pv_.y); r0[3] += car * bfhi(pv_.y);
                r1[0] += car * bflo(pv_.z); r1[1] += car * bfhi(pv_.z); r1[2] += car * bflo(pv_.w); r1[3] += car * bfhi(pv_.w); }
            u32x4 w; w.x = cvtpk_s(r0[0], r0[1]); w.y = cvtpk_s(r0[2], r0[3]); w.z = cvtpk_s(r1[0], r1[1]); w.w = cvtpk_s(r1[2], r1[3]);
            *(u32x4*)mp = w; }
    }
    asm volatile("s_waitcnt lgkmcnt(0)\n\ts_barrier" ::: "memory");
#undef DMA_K
#undef DMA_V
#undef BIAS
#undef START
#undef RESC
#undef ROT
#undef NEARCHK
}
struct G2 { static constexpr int LDS_V = NSLOT * SLOTB, LDS_WS = LDS_V + NSLOT * 2 * SLOTB, LDS_OST = LDS_WS + NW * 64 * 4, LDS_TBL = LDS_OST + NW * 4096, NTBL = GUARD + 1856, LDS_END = LDS_TBL + NTBL * 4; };
static_assert(G2::LDS_END + G2::NTBL * 4 <= 131072, "attention (V128) LDS map (two tables)");
template <int THRL, bool NS> __device__ __forceinline__ bool attn_unit_v128(const UnitDesc& U, lds_ptr shm) {
    int tid_ = threadIdx.x; asm volatile("" : "+v"(tid_));
    const int tid = tid_, lane = tid & 63, r32 = lane & 31, hi = lane >> 5; const int wid = __builtin_amdgcn_readfirstlane(tid >> 6);
    const int q0 = U.q0;
    const bf16h* Qw = U.Q + (long)(q0 + wid * QBLK) * DM;
    const bf16h* Kh = U.K + (long)U.kt0 * KVBLK * DM; const bf16h* Vh = U.V + (long)U.kt0 * KVBLK * DM;
    const unsigned lds0 = (unsigned)(uintptr_t)shm;
    ALDS float* wsf = (ALDS float*)(shm + G2::LDS_WS) + wid * 64;
    const bf16h* ksrc = Kh + (long)lane * DM + wid * 8;
    const bf16h* vsrc = Vh + (long)(16 * (wid & 3) + (lane >> 2)) * DM + (wid >> 2) * 32 + (lane & 3) * 8;
    const unsigned kdst = lds0 + LDS_K + wid * 1024, vdst = lds0 + G2::LDS_V + wid * 1024;
#define DMA_K(t, slot) glds16(ksrc + (long)(t) * KVBLK * DM, (unsigned)__builtin_amdgcn_readfirstlane(kdst + (slot)))
#define DMA_V(t, slot) do { glds16(vsrc + (long)(t) * KVBLK * DM, (unsigned)__builtin_amdgcn_readfirstlane(vdst + 2 * (slot))); glds16(vsrc + (long)(t) * KVBLK * DM + 64, (unsigned)__builtin_amdgcn_readfirstlane(vdst + 2 * (slot) + 8192)); } while (0)
    const lds_cptr Kbase = shm + LDS_K; bf16x8 kf[8];
    const lds_cptr shm3 = (lds_cptr)shm; const lds_cptr kp0 = shm3 + LDS_K + hi * 1024 + r32 * 16; const lds_cptr vp0 = shm3 + G2::LDS_V + ((lane >> 4) & 1) * 32 + (lane & 3) * 8 + (4 * hi + ((lane & 15) >> 2)) * 64;
    const lds_cptr tb0 = shm3 + G2::LDS_TBL + U.tbl_off + 4 * (G2::NTBL - 1 - GUARD - ((q0 - KVBLK * U.kt0) + QBLK * wid + r32 - 4 * hi));
    const int NT = U.NT;
    DMA_K(0, 0); DMA_V(0, 0); DMA_K(1, SLOTB);
    bf16x8 qr[4];
#pragma unroll
    for (int d0 = 0; d0 < 4; ++d0) qr[d0] = *reinterpret_cast<const bf16x8*>(&Qw[(long)r32 * DM + d0 * 16 + hi * 8]);
    float mhat = 0.f, l_reg = 0.f; f32x16 o[4]; o[0] = f32x16{}; o[1] = f32x16{}; o[2] = f32x16{}; o[3] = f32x16{}; asm volatile("" : "+v"(o[0]), "+v"(o[1]), "+v"(o[2]), "+v"(o[3]));
    const int NT_far = U.NT_far; float cb = (!NS && NT_far > 0) ? U.cfar : 0.f;
#define NSFLAG ((ALDS unsigned*)(shm + G2::LDS_END + G2::NTBL * 4))
    if constexpr (NS) { if (tid == 0) *NSFLAG = 0u; }
    const f32x16 zero16 = f32x16{};
#define BIAS(P0, P1, T0, T1, t) do { const ALDS float* tb_ = (const ALDS float*)(tb0 + 256 * (t)); \
    _Pragma("unroll") for (int r = 0; r < 16; ++r) T0[r] = tb_[(r & 3) + 8 * (r >> 2)]; \
    asm volatile("s_waitcnt lgkmcnt(0)" : "+v"(T0) :: "memory"); \
    _Pragma("unroll") for (int r = 0; r < 16; ++r) P0[r] += T0[r]; \
    _Pragma("unroll") for (int r = 0; r < 16; ++r) T0[r] = tb_[32 + (r & 3) + 8 * (r >> 2)]; \
    asm volatile("s_waitcnt lgkmcnt(0)" : "+v"(T0) :: "memory"); \
    _Pragma("unroll") for (int r = 0; r < 16; ++r) P1[r] += T0[r]; } while (0)
    bool resc = false;
#define START(P0, P1) do { resc = false; \
    if constexpr (!NS) { const float rm = rowmax(P0, P1); const float dl = rm < -1e30f ? 0.f : rm + cb; mhat = fadd_s(mhat, dl); const float mr = mhat - cb; \
      _Pragma("unroll") for (int r = 0; r < 16; ++r) { P0[r] = fsub_s(P0[r], mr); P1[r] = fsub_s(P1[r], mr); } } \
    _Pragma("unroll") for (int r = 0; r < 16; ++r) P0[r] = __builtin_amdgcn_exp2f(P0[r]); } while (0)
#define RESC() do { if (resc) { asm volatile("s_waitcnt lgkmcnt(0)" ::: "memory"); \
      _Pragma("unroll") for (int d_ = 0; d_ < 4; ++d_) _Pragma("unroll") for (int r = 0; r < 16; ++r) o[d_][r] *= wsf[crow(r, hi)]; } } while (0)
    f32x16 pA0, pA1, pB0, pB1;
    int sl_prev = 0, sl_cur = 0, sl_next = SLOTB;
#define ROT() do { sl_prev = sl_cur; sl_cur = sl_next; sl_next = (sl_next == (NSLOT - 1) * SLOTB) ? 0 : sl_next + SLOTB; } while (0)
#define NEARCHK(tn) do { if ((tn) == NT_far) cb = 0.f; } while (0)
#define FARSC(tt) do { if constexpr (NS) { if (NT_far > 0 && (tt) == NT_far) { const float Ffar = __builtin_amdgcn_exp2f(U.cfar); l_reg *= Ffar; \
      _Pragma("unroll") for (int d_ = 0; d_ < 4; ++d_) _Pragma("unroll") for (int r = 0; r < 16; ++r) o[d_][r] *= Ffar; } } } while (0)
    DMA_K(2, 2 * SLOTB);
    WAIT_BAR(4);
    { f32x16 z0; { float zz = 0.f; asm volatile("" : "+v"(zz)); _Pragma("unroll") for (int r = 0; r < 16; ++r) z0[r] = zz; }     qkt(pA0, pA1, Kbase, qr, z0, r32, hi); } asm volatile("s_nop 15\n\ts_nop 7" : "+v"(pA0), "+v"(pA1)); if (NT_far == 0) BIAS(pA0, pA1, pB0, pB1, 0);
    START(pA0, pA1);
    _Pragma("unroll") for (int r = 0; r < 16; ++r) pA1[r] = __builtin_amdgcn_exp2f(pA1[r]);
    WAIT_BAR(0);
    DMA_K(3, 0); DMA_V(1, SLOTB);
    ROT(); NEARCHK(1);
    kload8(kf, kp0 + sl_cur);
    WAIT_BAR(3);
    s16x4 vlo[8], vhi[8]; u32x4 pw0, pw1, pw2, pw3;
#define PKW(P, B) cvtpk_s(P[B], P[B + 1])
#define PAF(k) __builtin_bit_cast(bf16x8, pw##k)
#define VFR(i) (bf16x8){vlo[i][0], vlo[i][1], vlo[i][2], vlo[i][3], vhi[i][0], vhi[i][1], vhi[i][2], vhi[i][3]}
#define PIN(x) asm volatile("" : "+v"(x))
#define MX3(a, b, c) __builtin_fmaxf(__builtin_fmaxf((a), (b)), (c))
#define GAPA(MF, A0, A1, A2, A3, W0, W1, PW) do { MF; sacc += A0; sacc += A1; sacc += A2; sacc += A3; PIN(sacc); W0; W1; PIN(PW); SBAR(); } while (0)
#define EX(v) __builtin_amdgcn_exp2f(v)
#define GAPB(MF, X, B) do { MF; X[B] = EX(X[B]); X[B + 1] = EX(X[B + 1]); X[B + 2] = EX(X[B + 2]); X[B + 3] = EX(X[B + 3]); PIN(X); SBAR(); } while (0)
#define VRD(i) do { vlo[i] = vtr(vp_ + (((i) >> 2) * 4096 + ((i) & 3) * 1024)); vhi[i] = vtr(vp_ + (((i) >> 2) * 4096 + ((i) & 3) * 1024 + 512)); } while (0)
#define VRD2(i) do { vlo[i] = vtr(vp_ + ((((i) >> 2) + 2) * 4096 + ((i) & 3) * 1024)); vhi[i] = vtr(vp_ + ((((i) >> 2) + 2) * 4096 + ((i) & 3) * 1024 + 512)); } while (0)
#define GAPB2(MF, X, B) do { MF; if constexpr (NS) { X[B] = EX(X[B]); X[B + 1] = EX(X[B + 1]); } else { X[B] = EX(X[B] - mref_); X[B + 1] = EX(X[B + 1] - mref_); } PIN(X); SBAR(); } while (0)
#define KRD(G, j) do { if (G) { kload2(kf, kp0 + sl_next, j); SBAR(); } } while (0)
#define STEP(C0, C1, P0, P1, t, GK, GV, GL) do { SBAR(); \
    const lds_cptr vp_ = vp0 + 2 * sl_prev; \
    VRD(0); SBAR(); float sacc = (P0[0] + P0[1]); \
    GAPA(C0 = __builtin_amdgcn_mfma_f32_32x32x16_bf16(kf[0], qr[0], zero16, 0, 0, 0); PIN(kf[0]); PIN(qr[0]), P0[2], P0[3], P0[4], P0[5],     pw0[0] = PKW(P0, 0), pw0[1] = PKW(P0, 2), pw0); \
    VRD(4); SBAR(); GAPA(C1 = __builtin_amdgcn_mfma_f32_32x32x16_bf16(kf[1], qr[0], zero16, 0, 0, 0); PIN(kf[1]); PIN(qr[0]), P0[6], P0[7], P0[8], P0[9],     pw0[2] = PKW(P0, 4), pw0[3] = PKW(P0, 6), pw0); \
    VRD(1); SBAR(); GAPA(C0 = __builtin_amdgcn_mfma_f32_32x32x16_bf16(kf[2], qr[1], C0, 0, 0, 0),   P0[10], P0[11], P0[12], P0[13], pw1[0] = PKW(P0, 8), pw1[1] = PKW(P0, 10), pw1); \
    VRD(5); SBAR(); GAPA(C1 = __builtin_amdgcn_mfma_f32_32x32x16_bf16(kf[3], qr[1], C1, 0, 0, 0),   P0[14], P0[15], P1[0], P1[1],   pw1[2] = PKW(P0, 12), pw1[3] = PKW(P0, 14), pw1); \
    GAPA(C0 = __builtin_amdgcn_mfma_f32_32x32x16_bf16(kf[4], qr[2], C0, 0, 0, 0),   P1[2], P1[3], P1[4], P1[5],     pw2[0] = PKW(P1, 0), pw2[1] = PKW(P1, 2), pw2); \
    GAPA(C1 = __builtin_amdgcn_mfma_f32_32x32x16_bf16(kf[5], qr[2], C1, 0, 0, 0),   P1[6], P1[7], P1[8], P1[9],     pw2[2] = PKW(P1, 4), pw2[3] = PKW(P1, 6), pw2); \
    GAPA(C0 = __builtin_amdgcn_mfma_f32_32x32x16_bf16(kf[6], qr[3], C0, 0, 0, 0),   P1[10], P1[11], P1[12], P1[13], pw3[0] = PKW(P1, 8), pw3[1] = PKW(P1, 10), pw3); \
    GAPA(C1 = __builtin_amdgcn_mfma_f32_32x32x16_bf16(kf[7], qr[3], C1, 0, 0, 0),   P1[14], P1[15], 0.f, 0.f,       pw3[2] = PKW(P1, 12), pw3[3] = PKW(P1, 14), pw3); \
    l_reg += sacc; \
    if (GK) { DMA_K((t) + 3, sl_cur); } if (GV) { DMA_V((t) + 1, sl_next); } \
    if ((t) >= NT_far) BIAS(C0, C1, P0, P1, t); \
    resc = false; \
    if constexpr (!NS) { float a = MX3(C0[0], C0[1], C1[0]), b = MX3(C0[2], C0[3], C1[1]); a = MX3(a, C1[2], C1[3]); \
      _Pragma("unroll") for (int r = 4; r < 16; r += 4) { a = MX3(a, C0[r], C0[r + 1]); b = MX3(b, C0[r + 2], C0[r + 3]); a = MX3(a, C1[r], C1[r + 1]); b = MX3(b, C1[r + 2], C1[r + 3]); } \
      float rm = __builtin_fmaxf(a, b); { auto rr = __builtin_amdgcn_permlane32_swap(__float_as_uint(rm), __float_as_uint(rm), false, false); rm = __builtin_fmaxf(__uint_as_float(rr[0]), __uint_as_float(rr[1])); } \
      rm -= (mhat - cb); resc = false; \
      if (__builtin_expect(__any(rm > (float)THRL), 0)) { const float dl = __builtin_fmaxf(rm, 0.f); mhat += dl; \
        const float f = __builtin_amdgcn_exp2f(-dl); l_reg *= f; if (hi == 0) wsf[r32] = f; resc = true; } } \
    const float mref_ = mhat - cb; (void)mref_; \
    SBAR(); \
    VRD(2); VRD(6); SBAR(); \
    GAPB2(o[0] = __builtin_amdgcn_mfma_f32_32x32x16_bf16(PAF(0), VFR(0), o[0], 0, 0, 0), C0, 0); VRD(3); SBAR(); \
    GAPB2(o[1] = __builtin_amdgcn_mfma_f32_32x32x16_bf16(PAF(0), VFR(4), o[1], 0, 0, 0), C0, 2); VRD(7); SBAR(); \
    KRD(GL, 0); GAPB2(o[0] = __builtin_amdgcn_mfma_f32_32x32x16_bf16(PAF(1), VFR(1), o[0], 0, 0, 0), C0, 4); VRD2(0); VRD2(1); SBAR(); \
    KRD(GL, 1); GAPB2(o[1] = __builtin_amdgcn_mfma_f32_32x32x16_bf16(PAF(1), VFR(5), o[1], 0, 0, 0), C0, 6); VRD2(4); VRD2(5); SBAR(); \
    KRD(GL, 2); GAPB2(o[0] = __builtin_amdgcn_mfma_f32_32x32x16_bf16(PAF(2), VFR(2), o[0], 0, 0, 0), C0, 8); VRD2(2); SBAR(); \
    KRD(GL, 3); GAPB2(o[1] = __builtin_amdgcn_mfma_f32_32x32x16_bf16(PAF(2), VFR(6), o[1], 0, 0, 0), C0, 10); VRD2(6); SBAR(); \
    GAPB2(o[0] = __builtin_amdgcn_mfma_f32_32x32x16_bf16(PAF(3), VFR(3), o[0], 0, 0, 0), C0, 12); VRD2(3); SBAR(); \
    GAPB2(o[1] = __builtin_amdgcn_mfma_f32_32x32x16_bf16(PAF(3), VFR(7), o[1], 0, 0, 0), C0, 14); VRD2(7); SBAR(); \
    GAPB2(o[2] = __builtin_amdgcn_mfma_f32_32x32x16_bf16(PAF(0), VFR(0), o[2], 0, 0, 0), C1, 0); \
    GAPB2(o[3] = __builtin_amdgcn_mfma_f32_32x32x16_bf16(PAF(0), VFR(4), o[3], 0, 0, 0), C1, 2); \
    GAPB2(o[2] = __builtin_amdgcn_mfma_f32_32x32x16_bf16(PAF(1), VFR(1), o[2], 0, 0, 0), C1, 4); \
    GAPB2(o[3] = __builtin_amdgcn_mfma_f32_32x32x16_bf16(PAF(1), VFR(5), o[3], 0, 0, 0), C1, 6); \
    GAPB2(o[2] = __builtin_amdgcn_mfma_f32_32x32x16_bf16(PAF(2), VFR(2), o[2], 0, 0, 0), C1, 8); \
    GAPB2(o[3] = __builtin_amdgcn_mfma_f32_32x32x16_bf16(PAF(2), VFR(6), o[3], 0, 0, 0), C1, 10); \
    GAPB2(o[2] = __builtin_amdgcn_mfma_f32_32x32x16_bf16(PAF(3), VFR(3), o[2], 0, 0, 0), C1, 12); \
    GAPB2(o[3] = __builtin_amdgcn_mfma_f32_32x32x16_bf16(PAF(3), VFR(7), o[3], 0, 0, 0), C1, 14); \
    } while (0)
    int t = 1;
    for (; t + 5 < NT; t += 2) {
        STEP(pB0, pB1, pA0, pA1, t, true, true, true);     WAIT_BAR(3); RESC(); FARSC(t);     ROT(); NEARCHK(t + 1);
        STEP(pA0, pA1, pB0, pB1, t + 1, true, true, true); WAIT_BAR(3); RESC(); FARSC(t + 1); ROT(); NEARCHK(t + 2);
    }
#define ENDW(tt) do { if ((tt) + 3 < NT) { WAIT_BAR(3); } else if ((tt) + 2 < NT) { WAIT_BAR(2); } else { WAIT_BAR(0); } } while (0)
    for (; t + 1 < NT; t += 2) {
        STEP(pB0, pB1, pA0, pA1, t, (t + 3 < NT), (t + 1 < NT), (t + 1 < NT));         ENDW(t);     RESC(); FARSC(t);     ROT(); NEARCHK(t + 1);
        STEP(pA0, pA1, pB0, pB1, t + 1, (t + 4 < NT), (t + 2 < NT), (t + 2 < NT));     ENDW(t + 1); RESC(); FARSC(t + 1); ROT(); NEARCHK(t + 2);
    }
    STEP(pB0, pB1, pA0, pA1, NT - 1, false, false, false); RESC();
    { float sacc = pB0[0] + pB0[1]; _Pragma("unroll") for (int r = 2; r < 16; ++r) sacc += pB0[r]; _Pragma("unroll") for (int r = 0; r < 16; ++r) sacc += pB1[r]; l_reg += sacc;
      pw0 = (u32x4){PKW(pB0, 0), PKW(pB0, 2), PKW(pB0, 4), PKW(pB0, 6)}; pw1 = (u32x4){PKW(pB0, 8), PKW(pB0, 10), PKW(pB0, 12), PKW(pB0, 14)}; pw2 = (u32x4){PKW(pB1, 0), PKW(pB1, 2), PKW(pB1, 4), PKW(pB1, 6)}; pw3 = (u32x4){PKW(pB1, 8), PKW(pB1, 10), PKW(pB1, 12), PKW(pB1, 14)};
      int tidD = threadIdx.x; asm volatile("" : "+v"(tidD)); const int laneD = tidD & 63;
      const int vb0 = (int)(lds0 + G2::LDS_V) + ((laneD >> 4) & 1) * 32 + (laneD & 3) * 8 + (4 * (laneD >> 5) + ((laneD & 15) >> 2)) * 64;
      SBAR(); pv(o, vb0 + 2 * sl_cur, PAF(0), PAF(1), PAF(2), PAF(3)); pv(o + 2, vb0 + 2 * sl_cur + 8192, PAF(0), PAF(1), PAF(2), PAF(3)); }
#undef PKW
#undef PAF
#undef VFR
#undef PIN
#undef MX3
#undef GAPA
#undef GAPB
#undef GAPB2
#undef VRD2
#undef EX
#undef VRD
#undef KRD
#undef STEP
#undef FARSC
#undef ENDW
    int tidE = threadIdx.x; asm volatile("" : "+v"(tidE)); const int laneE = tidE & 63, r32E = laneE & 31, hiE = laneE >> 5;
    { auto rr = __builtin_amdgcn_permlane32_swap(__float_as_uint(l_reg), __float_as_uint(l_reg), false, false); l_reg = __uint_as_float(rr[0]) + __uint_as_float(rr[1]); }
    if constexpr (NS) {
        float om = 0.f;
#pragma unroll
        for (int d_ = 0; d_ < 4; ++d_)
#pragma unroll
            for (int r = 0; r < 16; ++r) om = __builtin_fmaxf(om, __builtin_fabsf(o[d_][r]));
        const bool okl = (l_reg > 0.f) && (l_reg < 1.2676506e30f) && (om < 3.0e38f);
        if (__any(!okl) && laneE == 0) *NSFLAG = 1u;
        asm volatile("s_waitcnt lgkmcnt(0)\n\ts_barrier" ::: "memory");
        const unsigned bad = *NSFLAG;
        asm volatile("s_waitcnt lgkmcnt(0)\n\ts_barrier" ::: "memory");
        if (bad) return true;
    }
    {
        if (hiE == 0) wsf[32 + r32E] = l_reg; asm volatile("s_waitcnt lgkmcnt(0)" ::: "memory");
        float rli[16];
#pragma unroll
        for (int r = 0; r < 16; ++r) rli[r] = __builtin_amdgcn_rcpf(wsf[32 + crow(r, hiE)]);
        ALDS unsigned short* stg = (ALDS unsigned short*)(shm + G2::LDS_OST) + wid * 2048;
        if (!U.comb) {
            bf16h* Ow = U.O + (long)(q0 + wid * QBLK) * DM;
#pragma unroll
            for (int pss = 0; pss < 2; ++pss) {
#pragma unroll
                for (int r = 0; r < 16; ++r) { const int orow = crow(r, hiE);
#pragma unroll
                    for (int d0 = 0; d0 < 2; ++d0) stg[orow * 64 + d0 * 32 + r32E] = __builtin_bit_cast(unsigned short, (__bf16)(o[2 * pss + d0][r] * rli[r])); }
                asm volatile("s_waitcnt lgkmcnt(0)" ::: "memory");
#pragma unroll
                for (int i = 0; i < 4; ++i) { const int row = i * 8 + (laneE >> 3), ch = laneE & 7; const u32x4 v = *(const ALDS u32x4*)(stg + row * 64 + ch * 8); *(u32x4*)(Ow + (long)row * DM + 64 * pss + ch * 8) = v; }
                asm volatile("s_waitcnt lgkmcnt(0)" ::: "memory");
            }
        } else {
            bf16h* Oc = U.O + (long)(q0 + wid * QBLK) * DM;
            const float LAMBDA_INIT = 0.8f - 0.6f * 0.7408182206817179f;
            float lam; { float d1 = AIN(7)[laneE] * AIN(8)[laneE], d2 = AIN(9)[laneE] * AIN(10)[laneE]; d1 = wave_sum(d1); d2 = wave_sum(d2); lam = __expf(d1) - __expf(d2) + LAMBDA_INIT; }
            const float* subln = AIN(11);
            float dv[2][4][8]; float ssq[4] = {0.f, 0.f, 0.f, 0.f};
#pragma unroll
            for (int pss = 0; pss < 2; ++pss) {
                unsigned long long ga[4][2];
#pragma unroll
                for (int i = 0; i < 4; ++i) { const int row = i * 8 + (laneE >> 3), ch = laneE & 7; const unsigned long long* gp = (const unsigned long long*)(Oc + (long)row * DM + 64 * pss + ch * 8);
                    ga[i][0] = __hip_atomic_load(gp, __ATOMIC_RELAXED, __HIP_MEMORY_SCOPE_AGENT); ga[i][1] = __hip_atomic_load(gp + 1, __ATOMIC_RELAXED, __HIP_MEMORY_SCOPE_AGENT); }
#pragma unroll
                for (int r = 0; r < 16; ++r) { const int orow = crow(r, hiE);
#pragma unroll
                    for (int d0 = 0; d0 < 2; ++d0) stg[orow * 64 + d0 * 32 + r32E] = __builtin_bit_cast(unsigned short, (__bf16)(o[2 * pss + d0][r] * rli[r])); }
                asm volatile("s_waitcnt lgkmcnt(0)" ::: "memory");
#pragma unroll
                for (int i = 0; i < 4; ++i) { const int row = i * 8 + (laneE >> 3), ch = laneE & 7; const u32x4 v1 = *(const ALDS u32x4*)(stg + row * 64 + ch * 8);
                    const unsigned long long g0 = ga[i][0], g1 = ga[i][1];
                    const unsigned a0w = (unsigned)g0, a1w = (unsigned)(g0 >> 32), a2w = (unsigned)g1, a3w = (unsigned)(g1 >> 32);
                    dv[pss][i][0] = bflo(a0w) - lam * bflo(v1.x); dv[pss][i][1] = bfhi(a0w) - lam * bfhi(v1.x); dv[pss][i][2] = bflo(a1w) - lam * bflo(v1.y); dv[pss][i][3] = bfhi(a1w) - lam * bfhi(v1.y);
                    dv[pss][i][4] = bflo(a2w) - lam * bflo(v1.z); dv[pss][i][5] = bfhi(a2w) - lam * bfhi(v1.z); dv[pss][i][6] = bflo(a3w) - lam * bflo(v1.w); dv[pss][i][7] = bfhi(a3w) - lam * bfhi(v1.w);
#pragma unroll
                    for (int e = 0; e < 8; ++e) ssq[i] += dv[pss][i][e] * dv[pss][i][e]; }
                asm volatile("s_waitcnt lgkmcnt(0)" ::: "memory");
            }
#pragma unroll
            for (int i = 0; i < 4; ++i) { float sv = ssq[i]; sv += __shfl_xor(sv, 1); sv += __shfl_xor(sv, 2); sv += __shfl_xor(sv, 4); ssq[i] = (1.0f - LAMBDA_INIT) / sqrtf(sv * (1.0f / 128.0f) + EPS); }
#pragma unroll
            for (int pss = 0; pss < 2; ++pss) { const int ch = laneE & 7;
                const f32x4 ga = *(const f32x4*)(subln + 64 * pss + ch * 8), gb = *(const f32x4*)(subln + 64 * pss + ch * 8 + 4);
#pragma unroll
                for (int i = 0; i < 4; ++i) { const int row = i * 8 + (laneE >> 3); const float rr = ssq[i];
                    u32x4 w; w.x = cvtpk_s(dv[pss][i][0] * rr * ga[0], dv[pss][i][1] * rr * ga[1]); w.y = cvtpk_s(dv[pss][i][2] * rr * ga[2], dv[pss][i][3] * rr * ga[3]);
                    w.z = cvtpk_s(dv[pss][i][4] * rr * gb[0], dv[pss][i][5] * rr * gb[1]); w.w = cvtpk_s(dv[pss][i][6] * rr * gb[2], dv[pss][i][7] * rr * gb[3]);
                    *(u32x4*)(Oc + (long)row * DM + 64 * pss + ch * 8) = w; } }
        }
    }
    asm volatile("s_waitcnt lgkmcnt(0)\n\ts_barrier" ::: "memory");
    return false;
#undef NSFLAG
#undef DMA_K
#undef DMA_V
#undef BIAS
#undef START
#undef RESC
#undef ROT
#undef NEARCHK
}
template <int MODE> __device__ __forceinline__ void build_table(lds_ptr shm, const float* gbt, int col, int dil) {
    ALDS float* tbl = (ALDS float*)(shm + Geo<MODE>::LDS_TBL);
    for (int i = threadIdx.x; i < Geo<MODE>::NTBL; i += NW * 64) { const int dist = i - GUARD; float v = MASKV;
        if (MODE == 0) { if (dist >= 0) v = gbt[col * GBT_N + (dist < GBT_N ? dist : GBT_N - 1)]; }
        else { if (dist >= 0 && dist <= 128) { const int dd = dist * dil; v = gbt[col * GBT_N + (dd < GBT_N ? dd : GBT_N - 1)]; } }
        tbl[i] = v; }
    asm volatile("s_waitcnt vmcnt(0) lgkmcnt(0)\n\ts_barrier" ::: "memory");
}
__device__ __forceinline__ void build_table_v128(lds_ptr shm, const float* gbt, int col, int off) {
    ALDS float* tbl = (ALDS float*)(shm + G2::LDS_TBL + off);
    for (int i = threadIdx.x; i < G2::NTBL; i += NW * 64) { const int dist = i - GUARD; tbl[G2::NTBL - 1 - i] = dist >= 0 ? gbt[col * GBT_N + (dist < GBT_N ? dist : GBT_N - 1)] : MASKV; }
    asm volatile("s_waitcnt vmcnt(0) lgkmcnt(0)\n\ts_barrier" ::: "memory");
}
#undef SBAR
#undef WAIT_BAR
}


typedef GAS unsigned gu32;
constexpr int CW_FIN = 16384;
constexpr int CW_BAR = 4096;
#define XB_TMO      128
#define XB_XCNT(j)  (256  + 64 * (j))
#define XB_XSUB(j)  (1280 + 64 * (j))
#define XB_XGEN(j)  (2304 + 64 * (j))
#define XB_TOP      3328
#define XB_TOPGEN   3392
#define XCD_BAR_WORDS 3456
#define XB_SPIN_CAP (1u << 18)
__device__ __forceinline__ unsigned xb_ld(unsigned* p)              { return __hip_atomic_load(p, __ATOMIC_RELAXED, __HIP_MEMORY_SCOPE_AGENT); }
__device__ __forceinline__ unsigned xb_add(unsigned* p, unsigned v) { return __hip_atomic_fetch_add(p, v, __ATOMIC_RELAXED, __HIP_MEMORY_SCOPE_AGENT); }
__device__ __forceinline__ unsigned xb_xcc_id() { return (unsigned)__builtin_amdgcn_s_getreg((3 << 11) | 20) & 0xFu; }
#define XB_SPIN(cond, bar) do { unsigned _sp = 0; while (cond) { __builtin_amdgcn_s_sleep(1); \
    if ((++_sp & 255u) == 0u) { if (xb_ld(&(bar)[XB_TMO])) break; if (_sp > XB_SPIN_CAP) { atomicAdd(&(bar)[XB_TMO], 1u); break; } } } } while (0)
struct XcdBarrier { unsigned* bar; unsigned x; volatile LAS unsigned* st; };
__device__ __forceinline__ XcdBarrier xcd_barrier_post(unsigned* bar, volatile LAS unsigned* st) {
    XcdBarrier b; b.bar = bar; b.x = xb_xcc_id(); b.st = st;
    if (threadIdx.x == 0) (void)xb_add(&bar[XB_XCNT(b.x)], 1u);
    return b;
}
__device__ __forceinline__ void xcd_barrier_complete(unsigned* bar, unsigned x, unsigned& nloc, unsigned& nx) {
    const unsigned G = gridDim.x * gridDim.y * gridDim.z;
    unsigned sum, cnt, mine, sp = 0u;
    for (;;) {
        sum = 0u; cnt = 0u; mine = 0u;
#pragma unroll
        for (unsigned j = 0; j < 16; ++j) { const unsigned c = xb_ld(&bar[XB_XCNT(j)]); sum += c; cnt += (c > 0u) ? 1u : 0u; mine = (j == x) ? c : mine; }
        if (sum == G) break;
        __builtin_amdgcn_s_sleep(1);
        if ((++sp & 255u) == 0u) { if (xb_ld(&bar[XB_TMO])) break; if (sp > XB_SPIN_CAP) { atomicAdd(&bar[XB_TMO], 1u); break; } }
    }
    nloc = mine > 0u ? mine : 1u; nx = cnt > 0u ? cnt : 1u;
}
__device__ __forceinline__ void xcd_barrier(const XcdBarrier& b) {
    asm volatile("s_waitcnt vmcnt(0)" ::: "memory");
    __syncthreads();
    if (threadIdx.x == 0) {
        unsigned* bar = b.bar;
        __builtin_amdgcn_s_waitcnt(0);
        unsigned nloc = b.st[0], nx = b.st[1];
        if (nloc == 0u) { xcd_barrier_complete(bar, b.x, nloc, nx); b.st[0] = nloc; b.st[1] = nx; }
        const unsigned old = xb_add(&bar[XB_XSUB(b.x)], 1u);
        const unsigned gen = old / nloc;
        if (old + 1u == (gen + 1u) * nloc) {
            __builtin_amdgcn_fence(__ATOMIC_RELEASE, "agent");
            asm volatile("s_waitcnt vmcnt(0)" ::: "memory");
            const unsigned og = xb_add(&bar[XB_TOP], 1u);
            const unsigned tg = og / nx;
            if (og + 1u == (tg + 1u) * nx) xb_add(&bar[XB_TOPGEN], 1u);
            else XB_SPIN(xb_ld(&bar[XB_TOPGEN]) == tg, bar);
            __builtin_amdgcn_fence(__ATOMIC_ACQUIRE, "agent");
            asm volatile("s_waitcnt vmcnt(0)" ::: "memory");
        } else {
            XB_SPIN(xb_ld(&bar[XB_TOPGEN]) == gen, bar);
            __builtin_amdgcn_fence(__ATOMIC_ACQUIRE, "agent");
            asm volatile("s_waitcnt vmcnt(0)" ::: "memory");
        }
    }
    __syncthreads();
}

constexpr int NWAVES = 8;
#ifndef DIFF_V128_V
#define DIFF_V128_V 1
#endif
constexpr bool DIFF_V128 = DIFF_V128_V != 0;
#ifndef DIL_MODE_V
#define DIL_MODE_V 1
#endif
constexpr int DIL_MODE = DIL_MODE_V;
constexpr int RING_BYTES = 131072, LDSCTL_OFF = RING_BYTES, MISC_OFF = LDSCTL_OFF + 320, LDS_BYTES = 147456;
enum Phase { PH_PRO = 0, PH_QKV_A0, PH_ATT_A0, PH_QKV_A1, PH_ATT_A1, PH_QKV_A2, PH_ATT_A2, PH_WO0, PH_UP0, PH_DOWN0, PH_PLE0,
             PH_QKV_B, PH_ATT_B, PH_COMB, PH_WO1, PH_UP1, PH_DOWN1, PH_PLE1, PH_FINAL, N_PHASES };


struct Frame {
    LAS unsigned char* lds; int tid, lane, wave, vcu, G;
};

struct P0Item { const float* W; bf16* WT; const float* gain; int K, N, item, pad; };
__device__ __forceinline__ void p0_item_load(const P0Item& d, f32x4 (&t)[8], f32x4 (&gq)[2], int lane) {
    const int nblk = d.N / 32, kb = d.item / nblk, nb = d.item % nblk, k0 = 64 * kb, n0 = 32 * nb;
#pragma unroll
    for (int i = 0; i < 8; ++i) t[i] = __builtin_nontemporal_load((const f32x4*)(d.W + (size_t)(k0 + (lane >> 3) + 8 * i) * d.N + n0 + 4 * (lane & 7)));
    if (d.gain) { const f32x4* gp = (const f32x4*)(d.gain + k0 + 8 * (lane & 7)); gq[0] = gp[0]; gq[1] = gp[1]; }
    else { gq[0] = (f32x4){1.f, 1.f, 1.f, 1.f}; gq[1] = gq[0]; }
}
__device__ __forceinline__ void p0_item_finish(const P0Item& d, const f32x4 (&t)[8], const f32x4 (&gq)[2], LAS float* scr, int lane) {
    const int nblk = d.N / 32, kb = d.item / nblk, nb = d.item % nblk, k0 = 64 * kb, n0 = 32 * nb;
#pragma unroll
    for (int i = 0; i < 8; ++i) { LAS float* p = scr + ((lane >> 3) + 8 * i) * 33 + 4 * (lane & 7); p[0] = t[i].x; p[1] = t[i].y; p[2] = t[i].z; p[3] = t[i].w; }
    asm volatile("s_waitcnt lgkmcnt(0)" ::: "memory");
    const int c = lane & 7;
#pragma unroll
    for (int j = 0; j < 4; ++j) { const int n = (lane >> 3) + 8 * j; const LAS float* sp = scr + (8 * c) * 33 + n;
        v4u o; o.x = pk2(sp[0 * 33] * gq[0].x, sp[1 * 33] * gq[0].y); o.y = pk2(sp[2 * 33] * gq[0].z, sp[3 * 33] * gq[0].w); o.z = pk2(sp[4 * 33] * gq[1].x, sp[5 * 33] * gq[1].y); o.w = pk2(sp[6 * 33] * gq[1].z, sp[7 * 33] * gq[1].w);
        *(v4u*)(d.WT + (size_t)(n0 + n) * d.K + k0 + 8 * c) = o; }
    asm volatile("s_waitcnt lgkmcnt(0)" ::: "memory");
}

constexpr int I_AQKV = (D / 64) * (NQKV_A / 32), I_DD = (D / 64) * (D / 32), I_BQKV = (D / 64) * (NQKV_B / 32), I_1 = (D / 64) * (FF / 32), I_2 = (FF / 64) * (D / 32), I_P = (PLE / 64) * (D / 32);
constexpr int NITEMS = I_AQKV + 2 * I_DD + I_BQKV + 2 * I_1 + 2 * I_2 + 2 * I_DD + 2 * I_P;
__device__ __forceinline__ P0Item p0_decode(int it) {
    unsigned char* ws = AWS;
    P0Item d; d.pad = 0; d.gain = nullptr; int r = it;
    if (r < I_AQKV) { d.W = AIN(3); d.gain = AIN(12); d.K = D; d.N = NQKV_A; d.WT = (bf16*)(ws + WS_WA_QKV); d.item = r; return d; } r -= I_AQKV;
    if (r < I_DD) { d.W = AIN(4); d.K = D; d.N = D; d.WT = (bf16*)(ws + WS_WA_O); d.item = r; return d; } r -= I_DD;
    if (r < I_BQKV) { d.W = AIN(5); d.gain = AIN(12) + D; d.K = D; d.N = NQKV_B; d.WT = (bf16*)(ws + WS_WB_QKV); d.item = r; return d; } r -= I_BQKV;
    if (r < I_DD) { d.W = AIN(6); d.K = D; d.N = D; d.WT = (bf16*)(ws + WS_WB_O); d.item = r; return d; } r -= I_DD;
    if (r < 2 * I_1) { const int li = r / I_1; d.W = AIN(14) + (size_t)li * D * FF; d.gain = AIN(13) + li * D; d.K = D; d.N = FF; d.WT = (bf16*)(ws + WS_W1 + li * 8 * MiB); d.item = r % I_1; return d; } r -= 2 * I_1;
    if (r < 2 * I_2) { const int li = r / I_2; d.W = AIN(15) + (size_t)li * D * FF; d.K = FF; d.N = D; d.WT = (bf16*)(ws + WS_W2 + li * 8 * MiB); d.item = r % I_2; return d; } r -= 2 * I_2;
    if (r < 2 * I_DD) { const int li = r / I_DD; d.W = AIN(17) + (size_t)li * D * D; d.gain = AIN(16) + li * D; d.K = D; d.N = D; d.WT = (bf16*)(ws + WS_WG + li * 2 * MiB); d.item = r % I_DD; return d; } r -= 2 * I_DD;
    { const int li = r / I_P; d.W = AIN(18) + (size_t)li * PLE * D; d.K = PLE; d.N = D; d.WT = (bf16*)(ws + WS_WP + li * (MiB / 2)); d.item = r % I_P; return d; }
}
constexpr int P_CHUNKS = 2;
__device__ __forceinline__ void p_chunk_load(int c, int gw, int lane, f32x4 (&t)[8]) {
    const f32x4* src = (const f32x4*)AIN(1); const size_t stride = (size_t)256 * NWAVES_C * 64;
#pragma unroll
    for (int j = 0; j < 8; ++j) t[j] = __builtin_nontemporal_load(src + (size_t)(c * 8 + j) * stride + (size_t)gw * 64 + lane);
}
__device__ __forceinline__ void p_chunk_store(int c, int gw, int lane, const f32x4 (&t)[8]) {
    v2u* dst = (v2u*)(AWS + WS_PB); const size_t stride = (size_t)256 * NWAVES_C * 64;
#pragma unroll
    for (int j = 0; j < 8; ++j) { v2u o; o.x = pk2(t[j].x, t[j].y); o.y = pk2(t[j].z, t[j].w); dst[(size_t)(c * 8 + j) * stride + (size_t)gw * 64 + lane] = o; }
}

__device__ __forceinline__ void phase_prologue(const Frame& F, const Args& a) {
    int tl_ = threadIdx.x; asm volatile("" : "+v"(tl_)); const int LANE = tl_ & 63;
    unsigned char* ws = AWS;
    LAS float* scr = (LAS float*)(F.lds + F.wave * 16384);
    const int gw = F.vcu * NWAVES + F.wave, NGW = F.G * NWAVES;
    {
        int it = gw; f32x4 ta[8], tb[8], ga[2], gb[2]; P0Item da = p0_decode(it < NITEMS ? it : 0), db = da;
        if (it < NITEMS) p0_item_load(da, ta, ga, LANE);
#pragma unroll 1
        while (it < NITEMS) {
            const int nx = it + NGW; const bool more = nx < NITEMS;
            if (more) { db = p0_decode(nx); p0_item_load(db, tb, gb, LANE); }
            p0_item_finish(da, ta, ga, scr, LANE);
            da = db; ga[0] = gb[0]; ga[1] = gb[1];
#pragma unroll
            for (int i = 0; i < 8; ++i) ta[i] = tb[i];
            it = nx;
        }
    }
    { f32x4 pt[8];
#pragma unroll 1
      for (int c = 0; c < P_CHUNKS; ++c) { p_chunk_load(c, gw, LANE, pt); p_chunk_store(c, gw, LANE, pt); } }
    {
        float* gbt = (float*)(ws + WS_GBT); const float* rb = AIN(2);
        for (int i = gw * 64 + LANE; i < 16 * GBT_N; i += NGW * 64) { const int c = i / GBT_N, n = i % GBT_N; gbt[i] = rb[rel_bucket(n) * 16 + c] * LOG2E; }
    }
    {
        const float* x = AIN(0); bf16* xa = (bf16*)(ws + WS_XA); float* ssq = (float*)(ws + WS_SSQ);
        for (int m = gw; m < M; m += 2 * NGW) {
            const f32x4* h0 = (const f32x4*)(x + (size_t)m * D) + LANE; const f32x4* h1 = (const f32x4*)(x + (size_t)(m + NGW) * D) + LANE;
            const f32x4 a0 = __builtin_nontemporal_load(h0), a1 = __builtin_nontemporal_load(h0 + 64), a2 = __builtin_nontemporal_load(h0 + 128), a3 = __builtin_nontemporal_load(h0 + 192), b0 = __builtin_nontemporal_load(h1), b1 = __builtin_nontemporal_load(h1 + 64), b2 = __builtin_nontemporal_load(h1 + 128), b3 = __builtin_nontemporal_load(h1 + 192);
            float sa = ((a0.x * a0.x + a0.y * a0.y) + (a0.z * a0.z + a0.w * a0.w)) + ((a1.x * a1.x + a1.y * a1.y) + (a1.z * a1.z + a1.w * a1.w))
                     + ((a2.x * a2.x + a2.y * a2.y) + (a2.z * a2.z + a2.w * a2.w)) + ((a3.x * a3.x + a3.y * a3.y) + (a3.z * a3.z + a3.w * a3.w));
            float sb = ((b0.x * b0.x + b0.y * b0.y) + (b0.z * b0.z + b0.w * b0.w)) + ((b1.x * b1.x + b1.y * b1.y) + (b1.z * b1.z + b1.w * b1.w))
                     + ((b2.x * b2.x + b2.y * b2.y) + (b2.z * b2.z + b2.w * b2.w)) + ((b3.x * b3.x + b3.y * b3.y) + (b3.z * b3.z + b3.w * b3.w));
            v2u* oa = (v2u*)(xa + (size_t)m * D) + LANE; v2u* ob = (v2u*)(xa + (size_t)(m + NGW) * D) + LANE; v2u o;
            o.x = pk2(a0.x, a0.y); o.y = pk2(a0.z, a0.w); oa[0] = o;   o.x = pk2(a1.x, a1.y); o.y = pk2(a1.z, a1.w); oa[64] = o;
            o.x = pk2(a2.x, a2.y); o.y = pk2(a2.z, a2.w); oa[128] = o; o.x = pk2(a3.x, a3.y); o.y = pk2(a3.z, a3.w); oa[192] = o;
            o.x = pk2(b0.x, b0.y); o.y = pk2(b0.z, b0.w); ob[0] = o;   o.x = pk2(b1.x, b1.y); o.y = pk2(b1.z, b1.w); ob[64] = o;
            o.x = pk2(b2.x, b2.y); o.y = pk2(b2.z, b2.w); ob[128] = o; o.x = pk2(b3.x, b3.y); o.y = pk2(b3.z, b3.w); ob[192] = o;
            sa = wave_sum(sa); sb = wave_sum(sb);
            if (LANE == 0) { *(f32x4*)(ssq + (size_t)m * 4) = (f32x4){sa, 0.f, 0.f, 0.f}; *(f32x4*)(ssq + (size_t)(m + NGW) * 4) = (f32x4){sb, 0.f, 0.f, 0.f}; }
        }
    }
}

__device__ __forceinline__ void phase_combine(const Frame& F, const Args& a) {
    int tl_ = threadIdx.x; asm volatile("" : "+v"(tl_)); const int LANE = tl_ & 63;
    unsigned char* ws = AWS;
    const float LAMBDA_INIT = 0.8f - 0.6f * 0.7408182206817179f;
    float d1 = AIN(7)[LANE] * AIN(8)[LANE], d2 = AIN(9)[LANE] * AIN(10)[LANE];
    d1 = wave_sum(d1); d2 = wave_sum(d2);
    const float lam = __expf(d1) - __expf(d2) + LAMBDA_INIT;
    const int gw = F.vcu * NWAVES + F.wave, NGW = F.G * NWAVES;
    bf16* O0 = (bf16*)(ws + WS_MIX); const bf16* O1 = (const bf16*)(ws + WS_XA);
    const float* sub = AIN(11) + (LANE & 7) * 16;
    float sg[16];
#pragma unroll
    for (int i = 0; i < 16; ++i) sg[i] = sub[i] * (1.0f - LAMBDA_INIT);
    for (int m = gw; m < M; m += NGW) {
        v4u* p0 = (v4u*)(O0 + (size_t)m * D + LANE * 16); const v4u* p1 = (const v4u*)(O1 + (size_t)m * D + LANE * 16);
        const v4u a0 = p0[0], a1 = p0[1], b0 = p1[0], b1 = p1[1];
        float v[16];
        v[0] = bflo(a0.x) - lam * bflo(b0.x); v[1] = bfhi(a0.x) - lam * bfhi(b0.x); v[2] = bflo(a0.y) - lam * bflo(b0.y); v[3] = bfhi(a0.y) - lam * bfhi(b0.y);
        v[4] = bflo(a0.z) - lam * bflo(b0.z); v[5] = bfhi(a0.z) - lam * bfhi(b0.z); v[6] = bflo(a0.w) - lam * bflo(b0.w); v[7] = bfhi(a0.w) - lam * bfhi(b0.w);
        v[8] = bflo(a1.x) - lam * bflo(b1.x); v[9] = bfhi(a1.x) - lam * bfhi(b1.x); v[10] = bflo(a1.y) - lam * bflo(b1.y); v[11] = bfhi(a1.y) - lam * bfhi(b1.y);
        v[12] = bflo(a1.z) - lam * bflo(b1.z); v[13] = bfhi(a1.z) - lam * bfhi(b1.z); v[14] = bflo(a1.w) - lam * bflo(b1.w); v[15] = bfhi(a1.w) - lam * bfhi(b1.w);
        float s = 0.f;
#pragma unroll
        for (int i = 0; i < 16; ++i) s += v[i] * v[i];
        s += __shfl_xor(s, 1); s += __shfl_xor(s, 2); s += __shfl_xor(s, 4);
        const float r = 1.0f / sqrtf(s * (1.0f / 128.0f) + EPS);
        v4u o0, o1;
        o0.x = pk2(v[0] * r * sg[0], v[1] * r * sg[1]); o0.y = pk2(v[2] * r * sg[2], v[3] * r * sg[3]); o0.z = pk2(v[4] * r * sg[4], v[5] * r * sg[5]); o0.w = pk2(v[6] * r * sg[6], v[7] * r * sg[7]);
        o1.x = pk2(v[8] * r * sg[8], v[9] * r * sg[9]); o1.y = pk2(v[10] * r * sg[10], v[11] * r * sg[11]); o1.z = pk2(v[12] * r * sg[12], v[13] * r * sg[13]); o1.w = pk2(v[14] * r * sg[14], v[15] * r * sg[15]);
        p0[0] = o0; p0[1] = o1;
    }
}

__device__ __forceinline__ void phase_final(const Frame& F, const Args& a) {
    int tl_ = threadIdx.x; asm volatile("" : "+v"(tl_)); const int LANE = tl_ & 63;
    const int gw = F.vcu * NWAVES + F.wave, NGW = F.G * NWAVES;
    const bf16* hb = (const bf16*)(AWS + WS_XA);
    const f32x4* gr = (const f32x4*)AIN(19) + 2 * LANE;
    const f32x4 g0 = gr[0], g1 = gr[1], g2 = gr[128], g3 = gr[129];
    for (int m = gw; m < M; m += NGW) {
        const v4u* hr = (const v4u*)(hb + (size_t)m * D) + LANE; const v4u w0 = hr[0], w1 = hr[64];
        const f32x4 v0 = {bflo(w0.x), bfhi(w0.x), bflo(w0.y), bfhi(w0.y)}, v1 = {bflo(w0.z), bfhi(w0.z), bflo(w0.w), bfhi(w0.w)};
        const f32x4 v2 = {bflo(w1.x), bfhi(w1.x), bflo(w1.y), bfhi(w1.y)}, v3 = {bflo(w1.z), bfhi(w1.z), bflo(w1.w), bfhi(w1.w)};
        float s = ((v0.x * v0.x + v0.y * v0.y) + (v0.z * v0.z + v0.w * v0.w)) + ((v1.x * v1.x + v1.y * v1.y) + (v1.z * v1.z + v1.w * v1.w))
                + ((v2.x * v2.x + v2.y * v2.y) + (v2.z * v2.z + v2.w * v2.w)) + ((v3.x * v3.x + v3.y * v3.y) + (v3.z * v3.z + v3.w * v3.w));
        const float r = 1.0f / sqrtf(wave_sum(s) * (1.0f / D) + EPS);
        f32x4* o = (f32x4*)(AOUT + (size_t)m * D) + 2 * LANE;
        o[0] = v0 * r * g0; o[1] = v1 * r * g1; o[128] = v2 * r * g2; o[129] = v3 * r * g3;
    }
}


template <int G> __device__ __forceinline__ void phase_attn_dil(const Frame& F) {
    int g = G, dil = 1 << (2 * G); asm volatile("" : "+s"(g), "+s"(dil));
    typedef float f32x16 __attribute__((ext_vector_type(16)));
    unsigned char* ws = AWS;
    int tid_ = threadIdx.x; asm volatile("" : "+v"(tid_));
    const int lane = tid_ & 63, r32 = lane & 31, hi = lane >> 5; const int wid = __builtin_amdgcn_readfirstlane(tid_ >> 6);
    const int h = F.vcu >> 4, mwg = F.vcu & 15;
    LAS float* tbl = (LAS float*)F.lds;
    { const float* gbt = (const float*)(ws + WS_GBT);
      if (tid_ < 192) { const int sd = tid_ - 31; float v = -__builtin_huge_valf();
          if (sd >= 0 && sd <= 128) { const int dd = sd * dil; v = gbt[h * GBT_N + (dd < GBT_N ? dd : GBT_N - 1)]; }
          tbl[191 - tid_] = v; }
      __syncthreads(); }
    const bf16* QK = (const bf16*)(ws + WS_QK); const bf16* KBk = QK + (size_t)M * D; const bf16* VT = (const bf16*)(ws + WS_VT);
    bf16* MIXb = (bf16*)(ws + WS_MIX); float* LSEb = (float*)(ws + WS_LSE);
    const int L = T / dil;
    const LAS float* tb = tbl + (32 - r32 + 4 * hi);
#pragma unroll 1
    for (int it = 0; it < 4; ++it) {
        const int qblk = mwg * 32 + it * 8 + wid; const int pos0 = qblk * 32;
        const int s0 = pos0 % L, seqbase = pos0 - s0; const int b = pos0 / T, rr = (pos0 % T) / L; const int tok0 = b * T + rr;
        bf16x8 qf[4]; bf16x8 kfr[5][4];
        { const bf16* qp = QK + ((((size_t)(pos0 >> 5) * 16 + h) * 8 + hi) * 32 + r32) * 8;
#pragma unroll
          for (int d0 = 0; d0 < 4; ++d0) qf[d0] = *(const bf16x8*)(qp + d0 * 512); }
#pragma unroll
        for (int i = 0; i < 5; ++i) {
            const int kt = s0 - 128 + 32 * i; const int ktc = kt >= 0 ? kt : 0;
            const bf16* kp = KBk + ((((size_t)((seqbase + ktc) >> 5) * 16 + h) * 8 + hi) * 32 + r32) * 8;
#pragma unroll
            for (int d0 = 0; d0 < 4; ++d0) kfr[i][d0] = *(const bf16x8*)(kp + d0 * 512);
        }
        f32x16 S[5];
#pragma unroll
        for (int i = 0; i < 5; ++i) {
            const int kt = s0 - 128 + 32 * i;
            f32x16 acc = {0.f, 0.f, 0.f, 0.f, 0.f, 0.f, 0.f, 0.f, 0.f, 0.f, 0.f, 0.f, 0.f, 0.f, 0.f, 0.f}; asm volatile("" : "+v"(acc));
            if (kt >= 0) {
                acc = __builtin_amdgcn_mfma_f32_32x32x16_bf16(kfr[i][0], qf[0], acc, 0, 0, 0);
                acc = __builtin_amdgcn_mfma_f32_32x32x16_bf16(kfr[i][1], qf[1], acc, 0, 0, 0);
                acc = __builtin_amdgcn_mfma_f32_32x32x16_bf16(kfr[i][2], qf[2], acc, 0, 0, 0);
                acc = __builtin_amdgcn_mfma_f32_32x32x16_bf16(kfr[i][3], qf[3], acc, 0, 0, 0);
            }
            S[i] = acc;
        }
        __builtin_amdgcn_sched_barrier(0);
        {
          f32x16 tv[5];
#pragma unroll
          for (int i = 0; i < 5; ++i)
#pragma unroll
            for (int r = 0; r < 16; ++r) tv[i][r] = tb[32 * i + ((r & 3) + 8 * (r >> 2))];
          asm volatile("s_waitcnt lgkmcnt(0)" : "+v"(tv[0]), "+v"(tv[1]), "+v"(tv[2]), "+v"(tv[3]), "+v"(tv[4]));
#pragma unroll
          for (int i = 0; i < 5; ++i) {
            const int kt = s0 - 128 + 32 * i;
#pragma unroll
            for (int r = 0; r < 16; ++r) S[i][r] = kt >= 0 ? S[i][r] + tv[i][r] : -__builtin_huge_valf();
          }
        }
        __builtin_amdgcn_sched_barrier(0);
        v4u vfr[5][2][2];
#pragma unroll
        for (int i = 0; i < 5; ++i) {
            const int kt = s0 - 128 + 32 * i; const int ktc = kt >= 0 ? kt : 0;
            const bf16* vp = VT + ((((size_t)((seqbase + ktc) >> 5) * 16 + h) * 8 + hi) * 32 + r32) * 8;
#pragma unroll
            for (int ks = 0; ks < 2; ++ks) { vfr[i][ks][0] = *(const v4u*)(vp + (ks * 4 + 0) * 256); vfr[i][ks][1] = *(const v4u*)(vp + (ks * 4 + 2) * 256); }
        }
        float mx = -__builtin_huge_valf();
#pragma unroll
        for (int i = 0; i < 5; ++i)
#pragma unroll
            for (int r = 0; r < 16; ++r) mx = fmaxf(mx, S[i][r]);
        mx = fmaxf(mx, __shfl_xor(mx, 32));
        float lsum = 0.f;
#pragma unroll
        for (int i = 0; i < 5; ++i)
#pragma unroll
            for (int r = 0; r < 16; ++r) { const float p = __builtin_amdgcn_exp2f(S[i][r] - mx); S[i][r] = p; lsum += p; }
        lsum += __shfl_xor(lsum, 32);
        f32x16 o0 = {0.f, 0.f, 0.f, 0.f, 0.f, 0.f, 0.f, 0.f, 0.f, 0.f, 0.f, 0.f, 0.f, 0.f, 0.f, 0.f}, o1 = o0; asm volatile("" : "+v"(o0), "+v"(o1));
        const int tokq = tok0 + (s0 + r32) * dil;
        float la_pre = 0.f; if (g > 0) la_pre = LSEb[(size_t)tokq * 16 + h];
#pragma unroll
        for (int i = 0; i < 5; ++i) {
            const int kt = s0 - 128 + 32 * i;
            if (kt >= 0) {
#pragma unroll
                for (int ks = 0; ks < 2; ++ks) {
                    v4u pa; pa.x = pg8::cvt_pk_bf16(S[i][8 * ks + 0], S[i][8 * ks + 1]); pa.y = pg8::cvt_pk_bf16(S[i][8 * ks + 2], S[i][8 * ks + 3]);
                    pa.z = pg8::cvt_pk_bf16(S[i][8 * ks + 4], S[i][8 * ks + 5]); pa.w = pg8::cvt_pk_bf16(S[i][8 * ks + 6], S[i][8 * ks + 7]);
                    o0 = __builtin_amdgcn_mfma_f32_32x32x16_bf16(__builtin_bit_cast(bf16x8, pa), __builtin_bit_cast(bf16x8, vfr[i][ks][0]), o0, 0, 0, 0);
                    o1 = __builtin_amdgcn_mfma_f32_32x32x16_bf16(__builtin_bit_cast(bf16x8, pa), __builtin_bit_cast(bf16x8, vfr[i][ks][1]), o1, 0, 0, 0);
                }
            }
        }
        float lse_g = mx + __builtin_amdgcn_logf(lsum);
        float ca = 0.f, cg = __builtin_amdgcn_rcpf(lsum), lse_new = lse_g;
        if (g > 0) { const float la = la_pre; const float Mx = fmaxf(la, lse_g); const float wa = __builtin_amdgcn_exp2f(la - Mx), wg = __builtin_amdgcn_exp2f(lse_g - Mx);
            const float inv = __builtin_amdgcn_rcpf(wa + wg); ca = wa * inv; cg = wg * inv * cg; lse_new = Mx + __builtin_amdgcn_logf(wa + wg); }
        if (hi == 0) LSEb[(size_t)tokq * 16 + h] = lse_new;
        asm volatile("s_nop 15\n\ts_nop 15\n\ts_nop 15\n\ts_nop 15" : "+v"(o0), "+v"(o1));
        unsigned short mv0[16], mv1[16];
        if (g > 0) {
#pragma unroll
            for (int r = 0; r < 16; ++r) { const int qrow = (r & 3) + 8 * (r >> 2) + 4 * hi; const bf16* mp = MIXb + (size_t)(tok0 + (s0 + qrow) * dil) * D + h * 64 + r32; mv0[r] = mp[0]; mv1[r] = mp[32]; }
        } else {
#pragma unroll
            for (int r = 0; r < 16; ++r) { mv0[r] = 0; mv1[r] = 0; }
        }
        asm volatile("" ::: "memory");
#pragma unroll
        for (int r = 0; r < 16; ++r) {
            const int qrow = (r & 3) + 8 * (r >> 2) + 4 * hi;
            const float cgr = __shfl(cg, qrow), car = __shfl(ca, qrow);
            bf16* mp = MIXb + (size_t)(tok0 + (s0 + qrow) * dil) * D + h * 64 + r32;
            const float v0 = o0[r] * cgr + car * bf2f(mv0[r]), v1 = o1[r] * cgr + car * bf2f(mv1[r]);
            mp[0] = (bf16)f2bf(v0); mp[32] = (bf16)f2bf(v1);
        }
    }
}
__device__ __forceinline__ void phase_attn_dil_valu(const Frame& F, int g, int dil) {
    unsigned char* ws = AWS;
    int tid_ = threadIdx.x; asm volatile("" : "+v"(tid_));
    const int lane = tid_ & 63; const int wid = __builtin_amdgcn_readfirstlane(tid_ >> 6);
    LAS float* sp = (LAS float*)F.lds + wid * 192;
    const bf16* QK = (const bf16*)(ws + WS_QK); const bf16* VT = (const bf16*)(ws + WS_VT); const float* gbt = (const float*)(ws + WS_GBT);
    bf16* MIX = (bf16*)(ws + WS_MIX); float* LSE = (float*)(ws + WS_LSE);
    const int L = T / dil;
#pragma unroll 1
    for (int wt = F.vcu * NWAVES + wid; wt < M * 16; wt += pg8::GRID * NWAVES) {
        const int h = wt & 15, pos = wt >> 4; const int s = pos % L; const int token = perm_to_token(pos, dil);
        const bf16* q = QK + (size_t)pos * 2048 + h * 64;
        float lg0 = -3e38f, lg1 = -3e38f, lg2 = -3e38f;
#pragma unroll
        for (int c = 0; c < 3; ++c) {
            const int sd = c * 64 + lane; float v = -3e38f;
            if (sd <= 128 && s - sd >= 0) {
                const bf16* k = QK + (size_t)(pos - sd) * 2048 + 1024 + h * 64; float acc = 0.f;
#pragma unroll
                for (int e = 0; e < 64; e += 8) { const v4u qa = *(const v4u*)(q + e), ka = *(const v4u*)(k + e);
                    acc += bflo(qa.x) * bflo(ka.x) + bfhi(qa.x) * bfhi(ka.x) + bflo(qa.y) * bflo(ka.y) + bfhi(qa.y) * bfhi(ka.y)
                         + bflo(qa.z) * bflo(ka.z) + bfhi(qa.z) * bfhi(ka.z) + bflo(qa.w) * bflo(ka.w) + bfhi(qa.w) * bfhi(ka.w); }
                { const int dd = sd * dil; v = acc + gbt[h * GBT_N + (dd < GBT_N ? dd : GBT_N - 1)]; }
            }
            if (c == 0) lg0 = v; else if (c == 1) lg1 = v; else lg2 = v;
        }
        const float mx = wave_max(fmaxf(fmaxf(lg0, lg1), lg2));
        const float p0 = lg0 > -1e38f ? exp2f(lg0 - mx) : 0.f, p1 = lg1 > -1e38f ? exp2f(lg1 - mx) : 0.f, p2 = lg2 > -1e38f ? exp2f(lg2 - mx) : 0.f;
        const float sum = wave_sum(p0 + p1 + p2);
        sp[lane] = p0; sp[64 + lane] = p1; sp[128 + lane] = p2;
        asm volatile("s_waitcnt lgkmcnt(0)" ::: "memory");
        const bf16* vt = VT + (size_t)(h * 64 + lane) * M + pos; const int nk = s < 128 ? s : 128;
        float o = 0.f;
        for (int sd = 0; sd <= nk; ++sd) o += sp[sd] * bf2f(vt[-sd]);
        asm volatile("s_waitcnt lgkmcnt(0)" ::: "memory");
        o /= sum; float lse2 = mx + log2f(sum);
        float* lsep = LSE + (size_t)token * 16 + h; bf16* mp = MIX + (size_t)token * D + h * 64 + lane;
        if (g > 0) { const float la = *lsep; const float Mx = fmaxf(la, lse2); const float wa = exp2f(la - Mx), wg = exp2f(lse2 - Mx);
            o = (wa * bf2f(*mp) + wg * o) / (wa + wg); lse2 = Mx + log2f(wa + wg); }
        *mp = (bf16)f2bf(o);
        if (lane == 0) *lsep = lse2;
    }
}
__device__ __forceinline__ void phase_attn_dil_pipe(const Frame& F, int g, int dil) {
    unsigned char* ws = AWS; att::lds_ptr shm = (att::lds_ptr)F.lds;
    const int h = F.vcu >> 4;
    att::build_table<1>(shm, (const float*)(ws + WS_GBT), h, dil);
    const int L = T / dil;
#pragma unroll 1
    for (int i = 0; i < 4; ++i) {
        const int blk = (F.vcu * 4 + i) & 63; const int pos0 = blk * 256; const int s0 = pos0 % L, seqbase = pos0 - s0;
        const int b = pos0 / T, r = (pos0 % T) / L;
        att::UnitDesc U;
        U.Q = (const att::bf16h*)(ws + WS_QB) + (size_t)seqbase * D + h * 64; U.K = (const att::bf16h*)(ws + WS_KB) + (size_t)seqbase * D + h * 64; U.V = (const att::bf16h*)(ws + WS_VB) + (size_t)seqbase * D + h * 64;
        U.q0 = s0; U.kt0 = s0 == 0 ? 0 : s0 / 64 - 2; U.NT = s0 == 0 ? 4 : 6; U.NT_far = 0; U.cfar = 0.f; U.tbl_off = 0; U.comb = 0;
        U.O = nullptr; U.MIXp = (att::bf16h*)(ws + WS_MIX) + h * 64; U.LSEp = (float*)(ws + WS_LSE) + h; U.tok0 = b * T + r; U.dil = dil; U.g = g;
        att::attn_unit<1, 8>(U, shm);
    }
}
__device__ __forceinline__ void phase_attn_dil_lds(const Frame& F, int g, int dil) {
    typedef __bf16 v2bf __attribute__((ext_vector_type(2)));
    unsigned char* ws = AWS;
    int tid_ = threadIdx.x; asm volatile("" : "+v"(tid_));
    const int lane = tid_ & 63, ql = lane & 31, hf = lane >> 5; const int wid = __builtin_amdgcn_readfirstlane(tid_ >> 6);
    const int h = F.vcu >> 4;
    constexpr int PITCH = 132, KL = 0, VL = 384 * PITCH, TB = 2 * 384 * PITCH;
    LAS unsigned char* lds = F.lds;
    if (tid_ < 129) { const int dd = tid_ * dil; ((LAS float*)(lds + TB))[tid_] = ((const float*)(ws + WS_GBT))[h * GBT_N + (dd < GBT_N ? dd : GBT_N - 1)]; }
    const int L = T / dil;
    const bf16* Qb = (const bf16*)(ws + WS_QB); const bf16* Kb = (const bf16*)(ws + WS_KB); const bf16* Vb = (const bf16*)(ws + WS_VB);
#pragma unroll 1
    for (int it = 0; it < 4; ++it) {
        const int blk = (F.vcu * 4 + it) & 63; const int pos0 = blk * 256; const int s0 = pos0 % L, seqbase = pos0 - s0;
        const int b = pos0 / T, rr = (pos0 % T) / L; const int tok0 = b * T + rr;
        const bf16* Kg = Kb + (size_t)seqbase * D + h * 64; const bf16* Vg = Vb + (size_t)seqbase * D + h * 64; const bf16* Qg = Qb + (size_t)seqbase * D + h * 64;
        __syncthreads();
#pragma unroll 2
        for (int c = tid_; c < 384 * 8; c += NWAVES * 64) {
            const int row = c >> 3, part = c & 7, srow = s0 - 128 + row;
            v4u kv = {0u, 0u, 0u, 0u}, vv = kv;
            if (srow >= 0) { kv = *(const v4u*)(Kg + (size_t)srow * D + part * 8); vv = *(const v4u*)(Vg + (size_t)srow * D + part * 8); }
            LAS unsigned* kd = (LAS unsigned*)(lds + KL + row * PITCH + part * 16); LAS unsigned* vd = (LAS unsigned*)(lds + VL + row * PITCH + part * 16);
            kd[0] = kv.x; kd[1] = kv.y; kd[2] = kv.z; kd[3] = kv.w; vd[0] = vv.x; vd[1] = vv.y; vd[2] = vv.z; vd[3] = vv.w;
        }
        __syncthreads();
        const int rho = wid * 32 + ql, sq = s0 + rho;
        unsigned qd[16];
        { const bf16* qp = Qg + (size_t)sq * D + hf * 32;
#pragma unroll
          for (int j = 0; j < 4; ++j) { const v4u t = *(const v4u*)(qp + 8 * j); qd[4 * j] = t.x; qd[4 * j + 1] = t.y; qd[4 * j + 2] = t.z; qd[4 * j + 3] = t.w; } }
        float o[32];
#pragma unroll
        for (int e = 0; e < 32; ++e) o[e] = 0.f;
        float l = 0.f, mref = 0.f;
        const LAS unsigned char* kbase = lds + KL + (rho + 128) * PITCH + hf * 64; const LAS unsigned char* vbase = lds + VL + (rho + 128) * PITCH + hf * 64;
        const LAS float* tbl = (const LAS float*)(lds + TB);
#pragma unroll 1
        for (int sd = 0; sd <= 128; ++sd) {
            const LAS unsigned* kp = (const LAS unsigned*)(kbase - sd * PITCH);
            float part = 0.f;
#pragma unroll
            for (int j = 0; j < 16; ++j) part = __builtin_amdgcn_fdot2_f32_bf16(__builtin_bit_cast(v2bf, qd[j]), __builtin_bit_cast(v2bf, kp[j]), part, false);
            const auto sw = __builtin_amdgcn_permlane32_swap(__float_as_uint(part), __float_as_uint(part), false, false);
            float logit = __uint_as_float(sw[0]) + __uint_as_float(sw[1]) + tbl[sd];
            if (sq - sd < 0) logit = -__builtin_huge_valf();
            if (sd == 0) mref = logit;
            float d = logit - mref;
            if (__any(d > 16.0f)) { const float dl = d > 0.f ? d : 0.f; mref += dl; d -= dl; const float f = __builtin_amdgcn_exp2f(-dl); l *= f;
#pragma unroll
                for (int e = 0; e < 32; ++e) o[e] *= f; }
            const float p = __builtin_amdgcn_exp2f(d);
            l += p;
            const LAS unsigned* vp = (const LAS unsigned*)(vbase - sd * PITCH);
#pragma unroll
            for (int j = 0; j < 16; ++j) { const unsigned w = vp[j]; o[2 * j] += p * bflo(w); o[2 * j + 1] += p * bfhi(w); }
        }
        const size_t tok = (size_t)tok0 + (size_t)sq * dil;
        float lse_g = mref + __builtin_amdgcn_logf(l);
        float ca = 0.f, cg = 1.0f / l, lse_new = lse_g;
        float* lsep = (float*)(ws + WS_LSE) + tok * 16 + h;
        if (g > 0) { const float la = *lsep; const float Mx = fmaxf(la, lse_g); const float wa = __builtin_amdgcn_exp2f(la - Mx), wg = __builtin_amdgcn_exp2f(lse_g - Mx);
            const float inv = 1.0f / (wa + wg); ca = wa * inv; cg = wg * inv * cg; lse_new = Mx + __builtin_amdgcn_logf(wa + wg); }
        bf16* mp = (bf16*)(ws + WS_MIX) + tok * D + h * 64 + hf * 32;
#pragma unroll
        for (int j = 0; j < 4; ++j) {
            float v[8];
#pragma unroll
            for (int e = 0; e < 8; ++e) v[e] = o[8 * j + e] * cg;
            if (g > 0) { const v4u pv_ = *(const v4u*)(mp + 8 * j);
                v[0] += ca * bflo(pv_.x); v[1] += ca * bfhi(pv_.x); v[2] += ca * bflo(pv_.y); v[3] += ca * bfhi(pv_.y);
                v[4] += ca * bflo(pv_.z); v[5] += ca * bfhi(pv_.z); v[6] += ca * bflo(pv_.w); v[7] += ca * bfhi(pv_.w); }
            v4u w; w.x = pk2(v[0], v[1]); w.y = pk2(v[2], v[3]); w.z = pk2(v[4], v[5]); w.w = pk2(v[6], v[7]);
            *(v4u*)(mp + 8 * j) = w;
        }
        if (hf == 0) *lsep = lse_new;
    }
    __syncthreads();
}
__device__ __forceinline__ void phase_attn_diff(const Frame& F, const Args& a) {
    unsigned char* ws = AWS; att::lds_ptr shm = (att::lds_ptr)F.lds;
    const int G8 = F.vcu >> 3, sidx = F.vcu & 7;
    { const int VH = 2 * G8; const int h = (VH >> 2) & 7, j = (VH >> 1) & 1; att::build_table<0>(shm, (const float*)(ws + WS_GBT), h * 2 + j, 1); }
#pragma unroll 1
    for (int it = 0; it < 8; ++it) {
        const int VH = 2 * G8 + (it >> 2); const int b = VH >> 5, h = (VH >> 2) & 7, j = (VH >> 1) & 1, c = VH & 1;
        const int i = it & 3; const int qb = i == 0 ? sidx : i == 1 ? 15 - sidx : i == 2 ? 16 + sidx : 31 - sidx;
        att::UnitDesc U;
        const size_t rb = (size_t)b * T * D;
        U.Q = (const att::bf16h*)(ws + WS_QB) + rb + h * 128 + j * 64; U.K = (const att::bf16h*)(ws + WS_KB) + rb + h * 128 + j * 64; U.V = (const att::bf16h*)(ws + WS_VB) + rb + h * 128 + c * 64;
        U.q0 = qb * 256; U.kt0 = 0; U.NT = 4 * qb + 4;
        U.NT_far = U.q0 >= 1576 ? (U.q0 - 1576) / 64 + 1 : 0; U.cfar = ((const float*)(ws + WS_GBT))[(h * 2 + j) * GBT_N + GBT_N - 1];
        U.tbl_off = 0; U.comb = 0;
        U.O = (att::bf16h*)(ws + (j == 0 ? WS_MIX : WS_XA)) + rb + h * 128 + c * 64;
        U.MIXp = nullptr; U.LSEp = nullptr; U.tok0 = 0; U.dil = 1; U.g = 0;
        att::attn_unit<0, 8>(U, shm);
    }
}

#define V128_UNIT_DESC(i) \
        const int j = (i) & 1; const int qb = ((i) >> 1) == 0 ? sidx : 31 - sidx; \
        att::UnitDesc U; \
        const size_t rb = (size_t)b * T * D; \
        U.Q = (const att::bf16h*)(ws + WS_QB) + rb + h * 128 + j * 64; U.K = (const att::bf16h*)(ws + WS_KB) + rb + h * 128 + j * 64; U.V = (const att::bf16h*)(ws + WS_VB) + rb + h * 128; \
        U.q0 = qb * 256; U.kt0 = 0; U.NT = 4 * qb + 4; \
        U.NT_far = U.q0 >= 1576 ? (U.q0 - 1576) / 64 + 1 : 0; U.cfar = gbt[(h * 2 + j) * GBT_N + GBT_N - 1]; U.tbl_off = j * att::G2::NTBL * 4; \
        U.O = (att::bf16h*)(ws + WS_MIX) + rb + h * 128; U.comb = j; \
        U.MIXp = nullptr; U.LSEp = nullptr; U.tok0 = 0; U.dil = 1; U.g = 0;
__device__ __forceinline__ void phase_attn_diff_v128(const Frame& F) {
    unsigned char* ws = AWS; att::lds_ptr shm = (att::lds_ptr)F.lds;
    const int BH = F.vcu >> 4, sidx = F.vcu & 15; const int b = BH >> 3, h = BH & 7;
    const float* gbt = (const float*)(ws + WS_GBT);
    att::build_table_v128(shm, gbt, h * 2 + 0, 0); att::build_table_v128(shm, gbt, h * 2 + 1, att::G2::NTBL * 4);
    unsigned redo = 0u;
#pragma unroll 1
    for (int i = 0; i < 4; ++i) {
        if ((i & 1) && ((redo >> (i - 1)) & 1u)) { redo |= 1u << i; continue; }
        V128_UNIT_DESC(i)
        if (att::attn_unit_v128<8, true>(U, shm)) redo |= 1u << i;
    }
    if (redo) {
#pragma unroll 1
        for (int i = 0; i < 4; ++i) {
            if (!((redo >> i) & 1u)) continue;
            V128_UNIT_DESC(i)
            (void)att::attn_unit_v128<8, false>(U, shm);
        }
    }
}
#undef V128_UNIT_DESC

__global__ void __launch_bounds__(NWAVES * 64, 2) mk_fwd(Args args) {
    extern __shared__ __attribute__((aligned(16))) unsigned char lds[];
    Frame F;
    F.lds = (LAS unsigned char*)lds;
    F.tid = 0; F.lane = 0; F.wave = __builtin_amdgcn_readfirstlane((int)threadIdx.x >> 6);
    F.G = gridDim.x; { const int bx = blockIdx.x; F.vcu = (F.G % 8 == 0) ? (bx % 8) * (F.G / 8) + bx / 8 : bx; }
    if (F.G != pg8::GRID) return;
    const int lo = args.ph_lo, hi = args.ph_hi;
#define IN(k) (lo <= (k) && (k) < hi)
    for (int u = threadIdx.x; u < (LDS_BYTES - LDSCTL_OFF) / 4; u += NWAVES * 64) ((LAS unsigned*)(F.lds + LDSCTL_OFF))[u] = 0u;
    __syncthreads();
    XcdBarrier bar; bar.bar = nullptr; bar.x = 0; bar.st = nullptr;
    if (hi - lo > 1) bar = xcd_barrier_post((unsigned*)(AWS + WS_CTL) + CW_BAR, (volatile LAS unsigned*)(F.lds + MISC_OFF) + 8);
#define SEAM(k) do { if (IN(k) && IN((k) + 1)) xcd_barrier(bar); } while (0)
    unsigned char* ws = AWS;
    const bf16* XA = (const bf16*)(ws + WS_XA);
#define HB_A ((bf16*)(ws + WS_XA))
#define HB_B ((bf16*)AOUT)
#define ssqp(i) ((float*)(ws + WS_SSQ + (size_t)(i) * SSQ_STRIDE))
    if (IN(PH_PRO)) phase_prologue(F, args);
    SEAM(PH_PRO);
#define QKV_A_GEMM_ROWMAJOR(g, DIL) { \
        pg8::Gemm gm{XA, (const bf16*)(ws + WS_WA_QKV) + (size_t)(g) * 3072 * D}; \
        pg8::EpiRowScale E{(bf16*)(ws + WS_QB), D, ssqp(0), DIL, 1, (size_t)M * D, C2, 0, 0}; \
        pg8::gemm_phase<pg8::EpiRowScale, true, M, NQKV_B, D, D, D, DIL, 1>(F.lds, gm, E); }
#define QKV_A_GEMM(g, DIL) { \
        { pg8::Gemm gm{XA, (const bf16*)(ws + WS_WA_QKV) + (size_t)(g) * 3072 * D}; \
          pg8::EpiRowScale E{(bf16*)(ws + WS_QK), D, ssqp(0), DIL, 1, (size_t)M * D, C2, 0, 1};     \
          pg8::gemm_phase<pg8::EpiRowScale, true, M, 2048, D, D, D, DIL, 1>(F.lds, gm, E); } \
        { pg8::Gemm gm{(const bf16*)(ws + WS_WA_QKV) + ((size_t)(g) * 3072 + 2048) * D, XA}; \
          pg8::EpiVT E{(bf16*)(ws + WS_VT), M, ssqp(0), DIL}; \
          pg8::gemm_phase<pg8::EpiVT, true, D, M, D, D, D, 1, DIL>(F.lds, gm, E); } }
#pragma unroll 1
    for (int g = 0; g < 3; ++g) {
        if (IN(PH_QKV_A0 + 2 * g)) { if (g == 0) QKV_A_GEMM(0, 1) else if (g == 1) QKV_A_GEMM(1, 4) else QKV_A_GEMM(2, 16) }
        SEAM(PH_QKV_A0 + 2 * g);
        if (IN(PH_ATT_A0 + 2 * g)) { if (g == 0) phase_attn_dil<0>(F); else if (g == 1) phase_attn_dil<1>(F); else phase_attn_dil<2>(F); }
        SEAM(PH_ATT_A0 + 2 * g);
    }
#define LAYER_TAIL(li, pb) \
    if (IN(pb)) {         \
        pg8::Gemm gm{(const bf16*)(ws + WS_MIX), (const bf16*)(ws + ((li) == 0 ? WS_WA_O : WS_WB_O))}; \
        pg8::EpiRes<false, false> E{(li) == 0 ? HB_A : HB_B, HB_A, ssqp(1 + 3 * (li)), nullptr, nullptr, nullptr, nullptr, nullptr};     \
        pg8::gemm_phase<pg8::EpiRes<false, false>, false, M, D, D, D, D, 1, 1>(F.lds, gm, E); \
    } \
    SEAM(pb); \
    if (IN((pb) + 1)) {     \
        pg8::Gemm gm{HB_A, (const bf16*)(ws + WS_W1 + (li) * 8 * MiB)}; \
        pg8::EpiRowScale E{(bf16*)(ws + WS_H), FF, ssqp(1 + 3 * (li)), 1, 0, 0, 1.0f, 1, 0}; \
        pg8::gemm_phase<pg8::EpiRowScale, true, M, FF, D, D, D, 1, 1>(F.lds, gm, E); \
    } \
    SEAM((pb) + 1); \
    if (IN((pb) + 2)) {     \
        pg8::Gemm gm{(const bf16*)(ws + WS_H), (const bf16*)(ws + WS_W2 + (li) * 8 * MiB)}; \
        pg8::EpiRes<false, false> E{HB_A, HB_A, ssqp(2 + 3 * (li)), nullptr, nullptr, nullptr, nullptr, nullptr}; \
        pg8::gemm_phase<pg8::EpiRes<false, false>, false, M, D, FF, FF, FF, 1, 1>(F.lds, gm, E); \
    } \
    SEAM((pb) + 2); \
    if (IN((pb) + 3)) {     \
        { pg8::Gemm gm{(const bf16*)(ws + WS_PB) + (size_t)(li) * M * PLE, (const bf16*)(ws + WS_WP + (li) * (MiB / 2))}; \
          pg8::EpiRowScale E{(bf16*)(ws + WS_PROJ), D, nullptr, 1, 0, 0, 1.0f, 0, 0}; \
          pg8::gemm_phase<pg8::EpiRowScale, true, M, D, PLE, PLE, PLE, 1, 1>(F.lds, gm, E); } \
        { pg8::Gemm gm{HB_A, (const bf16*)(ws + WS_WG + (li) * 2 * MiB)}; \
          pg8::EpiRes<false, (li) == 1> E{HB_A, HB_B  , ssqp((li) == 0 ? 3 : 6), ssqp(2 + 3 * (li)), (const bf16*)(ws + WS_PROJ), AOUT, AIN(19), (unsigned*)(ws + WS_CTL) + CW_FIN}; \
          pg8::gemm_phase<pg8::EpiRes<false, (li) == 1>, false, M, D, D, D, D, 1, 1>(F.lds, gm, E); } \
    } \
    SEAM((pb) + 3);
    LAYER_TAIL(0, PH_WO0)
    if (IN(PH_QKV_B)) {
        pg8::Gemm gm{HB_B, (const bf16*)(ws + WS_WB_QKV)};
        pg8::EpiRowScale E{(bf16*)(ws + WS_QB), D, ssqp(3), 1, 1, (size_t)M * D, C2, 0, 0};
        pg8::gemm_phase<pg8::EpiRowScale, true, M, NQKV_B, D, D, D, 1, 1>(F.lds, gm, E);
    }
    SEAM(PH_QKV_B);
    if (IN(PH_ATT_B)) { if (DIFF_V128) phase_attn_diff_v128(F); else phase_attn_diff(F, args); }
    SEAM(PH_ATT_B);
    if (!DIFF_V128) { if (IN(PH_COMB)) phase_combine(F, args); SEAM(PH_COMB); }
    LAYER_TAIL(1, PH_WO1)
#undef IN
}


#ifndef ONE_LAUNCH_V
#define ONE_LAUNCH_V 1
#endif
constexpr bool ONE_LAUNCH = ONE_LAUNCH_V != 0;
static void launch_mk(Args a, int lo, int hi, hipStream_t stream) {
    a.ph_lo = lo; a.ph_hi = hi;
    hipLaunchKernelGGL(mk_fwd, dim3(256), dim3(NWAVES * 64), LDS_BYTES, stream, a);
}
extern "C" void kernel_launch(void* const* d_in, const int* in_sizes, int n_in, void* d_out, int out_size, void* d_ws, size_t ws_size, hipStream_t stream) {
    static int ok = 0;
    if (ok == 0) {
        if (n_in != 20 || in_sizes[0] != M * D || out_size != M * D || ws_size < WS_END) { fprintf(stderr, "kernel_launch: unexpected shapes (n_in %d, in0 %d, out %d, ws %zu)\n", n_in, n_in > 0 ? in_sizes[0] : -1, out_size, ws_size); ok = -1; return; }
        if (hipFuncSetAttribute((const void*)mk_fwd, hipFuncAttributeMaxDynamicSharedMemorySize, LDS_BYTES) != hipSuccess) { fprintf(stderr, "kernel_launch: hipFuncSetAttribute failed\n"); ok = -1; return; }
        ok = 1;
    }
    if (ok < 0) return;
    unsigned char* ws = (unsigned char*)d_ws;
    (void)hipMemsetAsync(ws + WS_CTL, 0, CTL_ZERO_BYTES, stream);
    Args a{};
    for (int i = 0; i < 20; ++i) a.in[i] = (const float*)d_in[i];
    a.out = (float*)d_out; a.ws = ws;
    if (ONE_LAUNCH) { launch_mk(a, 0, (int)PH_FINAL, stream); return; }
    for (int ph = 0; ph < (int)PH_FINAL; ++ph) launch_mk(a, ph, ph + 1, stream);
}
```
